# Optimizing an MI355X kernel written in HIP

```python
import math
import numpy as np
import jax
import jax.numpy as jnp
from jax import lax

D_MODEL = 1024
BATCH = 8
SEQ = 2048
DEPTH = 4
DEC_BATCH = 128
DEC_SEQ = 1
PAST_LEN = 16384
PAGE_SIZE = 128

N_MIXERS = 2
N_SSD_LAYERS = (DEPTH + N_MIXERS - 1) // N_MIXERS
N_CM_LAYERS = DEPTH // N_MIXERS

SSD_EXPAND = 2
D_INNER = SSD_EXPAND * D_MODEL
SSD_HEAD_DIM = 64
SSD_HEADS = D_INNER // SSD_HEAD_DIM
SSD_GROUPS = 8
SSD_HPG = SSD_HEADS // SSD_GROUPS
SSD_STATE = 128
SSD_CONV_K = 4
SSD_CHUNK = 128
SSD_CONV_DIM = D_INNER + 2 * SSD_GROUPS * SSD_STATE
SSD_IN_DIM = D_INNER + SSD_CONV_DIM + SSD_HEADS

CM_CHUNK = 128
CM_WIDTH = 2 * D_MODEL
CM_GROUPS = 8
CM_GROUP_DIM = CM_WIDTH // CM_GROUPS

D_FF = 4 * D_MODEL

RMS_EPS = 1e-5

kernel_name = 'hybrid_ssd_chunkmlp_decoder_step'


def rmsnorm(x, g):
    xf = x.astype(jnp.float32)
    r = lax.rsqrt(jnp.mean(xf * xf, axis=-1, keepdims=True) + RMS_EPS)
    return (xf * r * g.astype(jnp.float32)).astype(x.dtype)


def ssd_scan(x, dt, A, B, C, h0):
    b, l = x.shape[:2]
    q = min(SSD_CHUNK, l)
    lp = -(-l // q) * q
    pad = lp - l
    if pad:
        pw = ((0, 0), (0, pad))
        x = jnp.pad(x, pw + ((0, 0), (0, 0)))
        dt = jnp.pad(dt, pw + ((0, 0),))
        B = jnp.pad(B, pw + ((0, 0), (0, 0)))
        C = jnp.pad(C, pw + ((0, 0), (0, 0)))
    nc = lp // q
    xc = x.reshape(b, nc, q, SSD_GROUPS, SSD_HPG, SSD_HEAD_DIM)
    dtc = dt.astype(jnp.float32).reshape(b, nc, q, SSD_GROUPS, SSD_HPG)
    Bc = B.reshape(b, nc, q, SSD_GROUPS, SSD_STATE)
    Cc = C.reshape(b, nc, q, SSD_GROUPS, SSD_STATE)
    a = dtc * A.astype(jnp.float32).reshape(SSD_GROUPS, SSD_HPG)
    a_cum = jnp.cumsum(a, axis=2)
    xdt = xc * dtc[..., None]
    ac = jnp.moveaxis(a_cum, 2, -1)
    seg = ac[..., :, None] - ac[..., None, :]
    causal = np.tril(np.ones((q, q), dtype=bool))
    decay = jnp.exp(jnp.where(causal, seg, -jnp.inf))
    cb = jnp.einsum('bcqgn,bcsgn->bcgqs', Cc, Bc)
    y_diag = jnp.einsum('bcgrqs,bcsgrp->bcqgrp', cb[:, :, :, None] * decay, xdt)
    decay_to_end = jnp.exp(a_cum[:, :, -1:] - a_cum)
    chunk_states = jnp.einsum('bcsgn,bcsgr,bcsgrp->bcgrpn', Bc, decay_to_end, xdt)
    chunk_decay = jnp.exp(a_cum[:, :, -1])

    def step(h, inp):
        s, d = inp
        return h * d[..., None, None] + s, h

    h_final, h_prev = lax.scan(step, h0.astype(jnp.float32),
                               (jnp.moveaxis(chunk_states, 1, 0), jnp.moveaxis(chunk_decay, 1, 0)))
    h_prev = jnp.moveaxis(h_prev, 0, 1)
    y_off = jnp.einsum('bcqgn,bcgrpn,bcqgr->bcqgrp', Cc, h_prev, jnp.exp(a_cum))
    y = (y_diag + y_off).reshape(b, lp, SSD_HEADS, SSD_HEAD_DIM)[:, :l]
    return y, h_final


def mamba2_mixer(h, conv_buf, ssm_state, w_in, conv_w, conv_b, dt_bias, a_log, d_skip, norm_g, w_out):
    b, l, _ = h.shape
    proj = h @ w_in
    z = proj[..., :D_INNER]
    xbc = proj[..., D_INNER:D_INNER + SSD_CONV_DIM]
    dt_raw = proj[..., D_INNER + SSD_CONV_DIM:]
    xbc_ext = jnp.concatenate([conv_buf.astype(xbc.dtype), xbc], axis=1)
    conv = conv_b + xbc_ext[:, 0:l] * conv_w[0]
    for k in range(1, SSD_CONV_K):
        conv = conv + xbc_ext[:, k:k + l] * conv_w[k]
    new_conv = xbc_ext[:, -(SSD_CONV_K - 1):]
    xbc_act = jax.nn.silu(conv)
    xs = xbc_act[..., :D_INNER].reshape(b, l, SSD_HEADS, SSD_HEAD_DIM)
    gn = SSD_GROUPS * SSD_STATE
    Bm = xbc_act[..., D_INNER:D_INNER + gn].reshape(b, l, SSD_GROUPS, SSD_STATE)
    Cm = xbc_act[..., D_INNER + gn:].reshape(b, l, SSD_GROUPS, SSD_STATE)
    dt = jax.nn.softplus(dt_raw.astype(jnp.float32) + dt_bias.astype(jnp.float32))
    A = -jnp.exp(a_log.astype(jnp.float32))
    h0 = ssm_state.reshape(b, SSD_GROUPS, SSD_HPG, SSD_HEAD_DIM, SSD_STATE)
    y, h_final = ssd_scan(xs, dt, A, Bm, Cm, h0)
    y = y + xs * d_skip[:, None]
    y = y.reshape(b, l, D_INNER) * jax.nn.silu(z)
    yg = y.astype(jnp.float32).reshape(b, l, SSD_GROUPS, D_INNER // SSD_GROUPS)
    yg = yg * lax.rsqrt(jnp.mean(yg * yg, axis=-1, keepdims=True) + RMS_EPS)
    y = (yg.reshape(b, l, D_INNER) * norm_g).astype(h.dtype)
    new_ssm = h_final.reshape(b, SSD_HEADS, SSD_HEAD_DIM, SSD_STATE)
    return y @ w_out, new_conv, new_ssm


def chunk_mlp_mixer(h, chunk_len, pos, w_in, b_in, v_g, w_s, b_s, w_out):
    b, l, _ = h.shape
    n = l // chunk_len
    gz = jax.nn.gelu(h @ w_in + b_in, approximate=False)
    u = gz[..., :CM_WIDTH]
    v = rmsnorm(gz[..., CM_WIDTH:], v_g)
    mask = np.tril(np.ones((chunk_len, chunk_len), dtype=bool))
    w = jnp.where(mask, w_s[:, pos][:, :, pos], 0)
    vc = v.reshape(b, n, chunk_len, CM_GROUPS, CM_GROUP_DIM)
    s = jnp.einsum('gts,bnsgd->bntgd', w, vc) + b_s[:, pos].T[:, :, None]
    out = u * s.reshape(b, l, CM_WIDTH).astype(u.dtype)
    return out @ w_out, v


def squared_relu_mlp(h, w_up, w_down):
    a = jax.nn.relu(h @ w_up)
    return (a * a) @ w_down


def trunk(x, conv0, ssm0, chunk_len, pos, p):
    new_conv, new_ssm, new_v = [], [], []
    for i in range(DEPTH):
        j = i // N_MIXERS
        h = rmsnorm(x, p['norm_mix_g'][i])
        if i % N_MIXERS == 0:
            out, c, s = mamba2_mixer(h, conv0[j], ssm0[j], p['ssd_w_in'][j], p['ssd_conv_w'][j],
                                     p['ssd_conv_b'][j], p['ssd_dt_bias'][j], p['ssd_a_log'][j],
                                     p['ssd_d'][j], p['ssd_norm_g'][j], p['ssd_w_out'][j])
            new_conv.append(c)
            new_ssm.append(s)
        else:
            out, v = chunk_mlp_mixer(h, chunk_len, pos, p['cm_w_in'][j], p['cm_b_in'][j],
                                     p['cm_v_norm_g'][j], p['cm_w_s'][j], p['cm_b_s'][j],
                                     p['cm_w_out'][j])
            new_v.append(v)
        x = x + out.astype(x.dtype)
        h2 = rmsnorm(x, p['norm_mlp_g'][i])
        x = x + squared_relu_mlp(h2, p['mlp_w_up'][i], p['mlp_w_down'][i]).astype(x.dtype)
    y = rmsnorm(x, p['norm_final_g'])
    return y, jnp.stack(new_conv), jnp.stack(new_ssm), jnp.stack(new_v)


def setup_inputs(seed: int = 0) -> dict:
    key = jax.random.key(seed)
    ks = jax.random.split(key, 24)
    f32 = jnp.float32
    nrm = lambda k, shape, scale: jax.random.normal(k, shape, f32) * scale
    x_prompt = nrm(ks[0], (BATCH, SEQ, D_MODEL), 1.0)
    x_sample = nrm(ks[1], (DEC_BATCH, DEC_SEQ, D_MODEL), 1.0)
    state_ssm = nrm(ks[2], (N_SSD_LAYERS, DEC_BATCH, SSD_HEADS, SSD_HEAD_DIM, SSD_STATE), 0.5)
    state_conv = nrm(ks[3], (N_SSD_LAYERS, DEC_BATCH, SSD_CONV_K - 1, SSD_CONV_DIM), 1.0)
    norm_mix_g = 1.0 + nrm(ks[4], (DEPTH, D_MODEL), 0.02)
    norm_mlp_g = 1.0 + nrm(ks[5], (DEPTH, D_MODEL), 0.02)
    norm_final_g = 1.0 + nrm(ks[6], (D_MODEL,), 0.02)
    ssd_w_in = nrm(ks[7], (N_SSD_LAYERS, D_MODEL, SSD_IN_DIM), D_MODEL ** -0.5)
    ssd_conv_w = nrm(ks[8], (N_SSD_LAYERS, SSD_CONV_K, SSD_CONV_DIM), SSD_CONV_K ** -0.5)
    ssd_conv_b = nrm(ks[9], (N_SSD_LAYERS, SSD_CONV_DIM), 0.01)
    u = jax.random.uniform(ks[10], (N_SSD_LAYERS, SSD_HEADS), f32)
    dt0 = jnp.exp(u * (math.log(0.1) - math.log(0.001)) + math.log(0.001))
    ssd_dt_bias = dt0 + jnp.log(-jnp.expm1(-dt0))
    ssd_a_log = jnp.log(jax.random.uniform(ks[11], (N_SSD_LAYERS, SSD_HEADS), f32, 1.0, 16.0))
    ssd_d = 1.0 + nrm(ks[12], (N_SSD_LAYERS, SSD_HEADS), 0.1)
    ssd_norm_g = 1.0 + nrm(ks[13], (N_SSD_LAYERS, D_INNER), 0.02)
    ssd_w_out = nrm(ks[14], (N_SSD_LAYERS, D_INNER, D_MODEL), D_INNER ** -0.5)
    cm_w_in = nrm(ks[15], (N_CM_LAYERS, D_MODEL, 2 * CM_WIDTH), D_MODEL ** -0.5)
    cm_b_in = nrm(ks[16], (N_CM_LAYERS, 2 * CM_WIDTH), 0.01)
    cm_v_norm_g = 1.0 + nrm(ks[17], (N_CM_LAYERS, CM_WIDTH), 0.02)
    row_scale = (jnp.arange(CM_CHUNK, dtype=f32) + 1.0) ** -0.5
    cm_w_s = nrm(ks[18], (N_CM_LAYERS, CM_GROUPS, CM_CHUNK, CM_CHUNK), 1.0) * row_scale[:, None]
    cm_b_s = 1.0 + nrm(ks[19], (N_CM_LAYERS, CM_GROUPS, CM_CHUNK), 0.1)
    cm_w_out = nrm(ks[20], (N_CM_LAYERS, CM_WIDTH, D_MODEL), CM_WIDTH ** -0.5)
    mlp_w_up = nrm(ks[21], (DEPTH, D_MODEL, D_FF), D_MODEL ** -0.5)
    mlp_w_down = nrm(ks[22], (DEPTH, D_FF, D_MODEL), D_FF ** -0.5)
    return {'x_prompt': x_prompt, 'x_sample': x_sample, 'state_ssm': state_ssm,
            'state_conv': state_conv, 'norm_mix_g': norm_mix_g, 'norm_mlp_g': norm_mlp_g,
            'norm_final_g': norm_final_g, 'ssd_w_in': ssd_w_in, 'ssd_conv_w': ssd_conv_w,
            'ssd_conv_b': ssd_conv_b, 'ssd_dt_bias': ssd_dt_bias, 'ssd_a_log': ssd_a_log,
            'ssd_d': ssd_d, 'ssd_norm_g': ssd_norm_g, 'ssd_w_out': ssd_w_out,
            'cm_w_in': cm_w_in, 'cm_b_in': cm_b_in, 'cm_v_norm_g': cm_v_norm_g,
            'cm_w_s': cm_w_s, 'cm_b_s': cm_b_s, 'cm_w_out': cm_w_out,
            'mlp_w_up': mlp_w_up, 'mlp_w_down': mlp_w_down}


def reference(x_prompt, x_sample, state_ssm, state_conv, norm_mix_g, norm_mlp_g, norm_final_g,
              ssd_w_in, ssd_conv_w, ssd_conv_b, ssd_dt_bias, ssd_a_log, ssd_d, ssd_norm_g,
              ssd_w_out, cm_w_in, cm_b_in, cm_v_norm_g, cm_w_s, cm_b_s, cm_w_out,
              mlp_w_up, mlp_w_down):
    p = {'norm_mix_g': norm_mix_g, 'norm_mlp_g': norm_mlp_g, 'norm_final_g': norm_final_g,
         'ssd_w_in': ssd_w_in, 'ssd_conv_w': ssd_conv_w, 'ssd_conv_b': ssd_conv_b,
         'ssd_dt_bias': ssd_dt_bias, 'ssd_a_log': ssd_a_log, 'ssd_d': ssd_d,
         'ssd_norm_g': ssd_norm_g, 'ssd_w_out': ssd_w_out, 'cm_w_in': cm_w_in,
         'cm_b_in': cm_b_in, 'cm_v_norm_g': cm_v_norm_g, 'cm_w_s': cm_w_s, 'cm_b_s': cm_b_s,
         'cm_w_out': cm_w_out, 'mlp_w_up': mlp_w_up, 'mlp_w_down': mlp_w_down}
    b = x_prompt.shape[0]
    conv0 = jnp.zeros((N_SSD_LAYERS, b, SSD_CONV_K - 1, SSD_CONV_DIM), x_prompt.dtype)
    ssm0 = jnp.zeros((N_SSD_LAYERS, b, SSD_HEADS, SSD_HEAD_DIM, SSD_STATE), jnp.float32)
    y_prompt, conv_p, ssm_p, _ = trunk(x_prompt, conv0, ssm0, CM_CHUNK, np.arange(CM_CHUNK), p)
    pos_s = (PAST_LEN + np.arange(DEC_SEQ)) % CM_CHUNK
    y_sample, conv_s, ssm_s, v_s = trunk(x_sample, state_conv, state_ssm, DEC_SEQ, pos_s, p)
    return (y_prompt, y_sample, ssm_p, conv_p, ssm_s, conv_s, v_s)
```

```cpp
#include <hip/hip_runtime.h>
#include <cstdio>
#include <cstdint>
#define MK_N_LAUNCHES 1
namespace pg8 {
#define PG8_LAS __attribute__((address_space(3)))
typedef unsigned short bf16_t;
typedef short bf16x8 __attribute__((ext_vector_type(8)));
typedef float f32x4 __attribute__((ext_vector_type(4)));
typedef unsigned u32x4 __attribute__((ext_vector_type(4)));
constexpr int BM = 256, BK = 64, HALF = 128, HTB = HALF * BK * 2  , STAGE_BYTES = 8 * HTB, NXCD = 8, WGM = 8;

__host__ __device__ __forceinline__ int lds_byte(int r, int c) { const int st = (r >> 4) * 2 + (c >> 5), rr = r & 15, cc = c & 31, ob = rr * 64 + cc * 2; return st * 1024 + (ob ^ (((ob >> 9) & 1) << 5)); }
__host__ __device__ __forceinline__ void stage_rc(int b, int& R, int& C) { const int st = b / 1024, sb = b % 1024, swz = sb ^ (((sb >> 9) & 1) << 5); R = (st >> 1) * 16 + swz / 64; C = (st & 1) * 32 + (swz % 64) / 2; }
__host__ __device__ __forceinline__ int perm32(int rho) { const int n = rho >> 4, i = rho & 15; return 8 * (i >> 2) + 4 * n + (i & 3); }

struct Unit { int pm, pn; };
struct Gemm { const bf16_t* A; const bf16_t* Bt; int M, N, K; };

struct StaticOrder {
    int nM, nN, nwg, G, c;
    __host__ __device__ void init(int M, int N, int G_, int c_) { nM = M / BM; nN = N / BM; nwg = nM * nN; G = G_; c = c_; }
    __host__ __device__ bool next(int i, Unit& u) const {
        const long L = (long)i * G + c; if (L >= nwg) return false;
        int wgid = (int)L; { const int q = nwg / NXCD, r = nwg % NXCD, xcd = wgid % NXCD, off = wgid / NXCD; wgid = (xcd < r ? xcd * (q + 1) : r * (q + 1) + (xcd - r) * q) + off; }
        const int nig = WGM * nN, gid = wgid / nig, fm = gid * WGM, gsz = (nM - fm) < WGM ? (nM - fm) : WGM;
        u.pm = fm + ((wgid % nig) % gsz); u.pn = (wgid % nig) / gsz; return true;
    }
    __device__ __forceinline__ void a_ready(const Unit&) const {}
    __device__ __forceinline__ void done(const Unit&) const {}
};
__device__ __forceinline__ unsigned cvt_pk_bf16(float lo, float hi) { unsigned r; asm volatile("v_cvt_pk_bf16_f32 %0, %1, %2" : "=v"(r) : "v"(lo), "v"(hi)); return r; }
typedef float f32x2 __attribute__((ext_vector_type(2)));
__device__ __forceinline__ f32x2 gelu_pk(f32x2 v) {
    const f32x2 av = __builtin_elementwise_abs(v), d = av * 0.2316418882f + 1.0f;
    f32x2 t; t.x = __builtin_amdgcn_rcpf(d.x); t.y = __builtin_amdgcn_rcpf(d.y);
    f32x2 q = t * 0.5307027145f + (-0.7265760135f); q = q * t + 0.7107068705f; q = q * t + (-0.142248368f); q = q * t + 0.127414796f; q = q * t;
    const f32x2 s = (v * v) * (-0.72134752044f);
    f32x2 e; e.x = __builtin_amdgcn_exp2f(s.x); e.y = __builtin_amdgcn_exp2f(s.y);
    const f32x2 m = v * (q * e), r = v - m;
    f32x2 o; o.x = v.x < 0.f ? m.x : r.x; o.y = v.y < 0.f ? m.y : r.y; return o;
}
template <class Epi, class Sched, bool ALIGN_EPI = false, bool SP2 = false, bool TILED_A = false>
__device__ __forceinline__ void gemm_phase(PG8_LAS unsigned char* lds, const Gemm g, const Sched& S, const Epi& E, const int wave_id) {
    unsigned ones_l = ~0u; asm volatile("" : "+s"(ones_l)); const int tid_l = wave_id * 64 + (int)__builtin_amdgcn_mbcnt_hi(ones_l, __builtin_amdgcn_mbcnt_lo(ones_l, 0u));
    const int tid = tid_l, wid = __builtin_amdgcn_readfirstlane(tid >> 6), lane = tid & 63, wr = wid >> 2, wc = wid & 3, fr = lane & 15, fq = lane >> 4;
    const int K = g.K, nt = K / BK;
    unsigned voffA[2], voffB[2];
#pragma unroll
    for (int i = 0; i < 2; ++i) { int R, C; stage_rc(tid * 16 + i * 8192, R, C); const int Rb = Epi::PERM ? ((R & ~31) + perm32(R & 31)) : R;
        voffA[i] = (unsigned)(R * (TILED_A ? BK : K) + C) * 2u; voffB[i] = (unsigned)(Rb * K + C) * 2u; }
    const size_t kstep = (size_t)(BK * 2);
    const size_t hstep = (size_t)HALF * K * 2;
    const size_t tstep = 2 * hstep;
    const size_t kstepA = TILED_A ? (size_t)(2 * HALF * BK * 2) : kstep, hstepA = TILED_A ? (size_t)(HALF * BK * 2) : hstep, tstepA = TILED_A ? (size_t)nt * (2 * HALF * BK * 2) : tstep;
    const unsigned ldsw = (unsigned)wid * 1024u;
    const int aoff = lds_byte(wr * 64 + fr, fq * 8), boff = lds_byte(wc * 32 + fr, fq * 8);
#define PG8_SA(b, h) (((b) * 2 + (h)) * HTB)
#define PG8_SB(b, h) ((4 + (b) * 2 + (h)) * HTB)
#define PG8_STAGE(bufoff, gbase, voff) do { _Pragma("unroll") for (int _i = 0; _i < 2; ++_i) \
        __builtin_amdgcn_global_load_lds((const unsigned*)((const char*)(gbase) + (voff)[_i]), (PG8_LAS unsigned*)(lds + (bufoff) + ldsw + _i * 8192), 16, 0, 0); } while (0)
#define PG8_LDA(dst, b, h) do { _Pragma("unroll") for (int m = 0; m < 4; ++m) _Pragma("unroll") for (int k = 0; k < 2; ++k) dst[m][k] = *(const PG8_LAS bf16x8*)(lds + PG8_SA(b, h) + aoff + m * 2048 + k * 1024); } while (0)
#define PG8_LDB(dst, b, h) do { _Pragma("unroll") for (int n = 0; n < 2; ++n) _Pragma("unroll") for (int k = 0; k < 2; ++k) dst[n][k] = *(const PG8_LAS bf16x8*)(lds + PG8_SB(b, h) + boff + n * 2048 + k * 1024); } while (0)
#define PG8_MMA(ai, bj, At, Bt) do { __builtin_amdgcn_s_setprio(1); _Pragma("unroll") for (int m = 0; m < 4; ++m) _Pragma("unroll") for (int n = 0; n < 2; ++n) _Pragma("unroll") for (int k = 0; k < 2; ++k) \
        acc[ai][bj][m][n] = __builtin_amdgcn_mfma_f32_16x16x32_bf16(Bt[n][k], At[m][k], acc[ai][bj][m][n], 0, 0, 0); __builtin_amdgcn_s_setprio(0); } while (0)
#define PG8_WAIT_V(n) asm volatile("s_waitcnt vmcnt(" #n ")" ::: "memory")
#define PG8_WAIT_L(n) asm volatile("s_waitcnt lgkmcnt(" #n ")" ::: "memory")
#define PG8_BAR __builtin_amdgcn_s_barrier()
#define PG8_SCHED __builtin_amdgcn_sched_barrier(0)
    Unit cur, nxt; int ui = 0;
    if (!S.next(0, cur)) return;
    f32x4 acc[2][2][4][2];
#pragma unroll
    for (int a = 0; a < 2; ++a)
#pragma unroll
        for (int b = 0; b < 2; ++b)
#pragma unroll
            for (int m = 0; m < 4; ++m)
#pragma unroll
                for (int n = 0; n < 2; ++n) acc[a][b][m][n] = (f32x4){0.f, 0.f, 0.f, 0.f};
    bf16x8 At[4][2], B0[2][2], B1[2][2];
    const char* cA = (const char*)g.A + (size_t)cur.pm * tstepA; const char* cB = (const char*)g.Bt + (size_t)cur.pn * tstep;
    S.a_ready(cur);
    if constexpr (SP2) {
        PG8_STAGE(PG8_SB(0, 0), cB, voffB); PG8_STAGE(PG8_SB(0, 1), cB + hstep, voffB); PG8_STAGE(PG8_SA(0, 0), cA, voffA); PG8_STAGE(PG8_SA(0, 1), cA + hstepA, voffA);
        E.pre(tid);
        if (wr == 1) PG8_BAR;
        PG8_WAIT_V(2); PG8_BAR;
        PG8_STAGE(PG8_SB(1, 0), cB + kstep, voffB); PG8_STAGE(PG8_SA(1, 0), cA + kstepA, voffA); PG8_STAGE(PG8_SB(1, 1), cB + hstep + kstep, voffB);
        PG8_WAIT_V(6); PG8_BAR;
    } else {
        PG8_STAGE(PG8_SB(0, 0), cB, voffB); PG8_STAGE(PG8_SA(0, 0), cA, voffA); PG8_STAGE(PG8_SB(0, 1), cB + hstep, voffB); PG8_STAGE(PG8_SA(0, 1), cA + hstepA, voffA);
        E.pre(tid);
        if (wr == 1) PG8_BAR;
        PG8_WAIT_V(4); PG8_BAR;
        PG8_STAGE(PG8_SB(1, 0), cB + kstep, voffB); PG8_STAGE(PG8_SA(1, 0), cA + kstepA, voffA); PG8_STAGE(PG8_SB(1, 1), cB + hstep + kstep, voffB);
        PG8_WAIT_V(6); PG8_BAR;
    }
    for (;;) {
        const bool has_next = S.next(ui + 1, nxt);
        const char* nA = has_next ? (const char*)g.A + (size_t)nxt.pm * tstepA : cA; const char* nB = has_next ? (const char*)g.Bt + (size_t)nxt.pn * tstep : cB;
        for (int t = 0; t < nt; t += 2) {
if constexpr (Epi::KHOOK) { asm volatile("" : "+v"(voffA[0]), "+v"(voffA[1]), "+v"(voffB[0]), "+v"(voffB[1])); }
            if constexpr (Epi::KHOOK) E.khook(acc, t, wr, fr);
            const bool last = (t == nt - 2);
            const char* a1 = cA + (size_t)(t + 1) * kstepA;
            const char* a2 = last ? nA : cA + (size_t)(t + 2) * kstepA; const char* b2 = last ? nB : cB + (size_t)(t + 2) * kstep;
            const char* a3 = a2 + kstepA; const char* b3 = b2 + kstep;
            if (last && has_next) S.a_ready(nxt);
            if constexpr (SP2) {
            PG8_LDB(B0, 0, 0); PG8_LDB(B1, 0, 1); PG8_SCHED; PG8_LDA(At, 0, 0); PG8_STAGE(PG8_SA(1, 1), a1 + hstepA, voffA);
            PG8_WAIT_V(8); PG8_WAIT_L(0); PG8_BAR; PG8_MMA(0, 0, At, B0); PG8_MMA(0, 1, At, B1); PG8_BAR; PG8_SCHED;
            PG8_LDA(At, 0, 1); PG8_STAGE(PG8_SB(0, 0), b2, voffB); PG8_STAGE(PG8_SB(0, 1), b2 + hstep, voffB); PG8_STAGE(PG8_SA(0, 0), a2, voffA);
            PG8_WAIT_V(8); PG8_WAIT_L(0); PG8_BAR; PG8_MMA(1, 0, At, B0); PG8_MMA(1, 1, At, B1); PG8_BAR; PG8_SCHED;
            PG8_LDB(B0, 1, 0); PG8_LDB(B1, 1, 1); PG8_SCHED; PG8_LDA(At, 1, 0); PG8_STAGE(PG8_SA(0, 1), a2 + hstepA, voffA);
            PG8_WAIT_V(8); PG8_WAIT_L(0); PG8_BAR; PG8_MMA(0, 0, At, B0); PG8_MMA(0, 1, At, B1); PG8_BAR; PG8_SCHED;
            PG8_LDA(At, 1, 1); PG8_STAGE(PG8_SB(1, 0), b3, voffB); PG8_STAGE(PG8_SB(1, 1), b3 + hstep, voffB); PG8_STAGE(PG8_SA(1, 0), a3, voffA);
            PG8_WAIT_V(8); PG8_WAIT_L(0); PG8_BAR; PG8_MMA(1, 0, At, B0); PG8_MMA(1, 1, At, B1); PG8_BAR; PG8_SCHED;
            } else {
            PG8_LDB(B0, 0, 0); PG8_SCHED; PG8_LDA(At, 0, 0); PG8_STAGE(PG8_SA(1, 1), a1 + hstepA, voffA);
            PG8_WAIT_L(8); PG8_BAR; PG8_WAIT_L(0); PG8_MMA(0, 0, At, B0); PG8_BAR; PG8_SCHED;
            PG8_LDB(B1, 0, 1); PG8_STAGE(PG8_SB(0, 0), b2, voffB);
            PG8_BAR; PG8_WAIT_L(0); PG8_MMA(0, 1, At, B1); PG8_BAR;
            PG8_LDA(At, 0, 1); PG8_STAGE(PG8_SA(0, 0), a2, voffA);
            PG8_BAR; PG8_WAIT_L(0); PG8_MMA(1, 0, At, B0); PG8_BAR; PG8_SCHED;
            PG8_STAGE(PG8_SB(0, 1), b2 + hstep, voffB);
            PG8_WAIT_V(6); PG8_BAR; PG8_MMA(1, 1, At, B1); PG8_BAR;
            PG8_LDB(B0, 1, 0); PG8_SCHED; PG8_LDA(At, 1, 0); PG8_STAGE(PG8_SA(0, 1), a2 + hstepA, voffA);
            PG8_WAIT_L(8); PG8_BAR; PG8_WAIT_L(0); PG8_MMA(0, 0, At, B0); PG8_BAR; PG8_SCHED;
            PG8_LDB(B1, 1, 1); PG8_STAGE(PG8_SB(1, 0), b3, voffB);
            PG8_BAR; PG8_WAIT_L(0); PG8_MMA(0, 1, At, B1); PG8_BAR;
            PG8_LDA(At, 1, 1); PG8_STAGE(PG8_SA(1, 0), a3, voffA);
            PG8_BAR; PG8_WAIT_L(0); PG8_MMA(1, 0, At, B0); PG8_BAR; PG8_SCHED;
            PG8_STAGE(PG8_SB(1, 1), b3 + hstep, voffB);
            PG8_WAIT_V(6); PG8_BAR; PG8_MMA(1, 1, At, B1); PG8_BAR;
            }
        }
        if constexpr (ALIGN_EPI) { if (wr == 0) PG8_BAR; }
        if constexpr (!Epi::AFTER_DRAIN) { E(acc, cur, wr, wc, fr, fq); S.done(cur); }
        if (!has_next) break;
#pragma unroll
        for (int a = 0; a < 2; ++a)
#pragma unroll
            for (int b = 0; b < 2; ++b)
#pragma unroll
                for (int m = 0; m < 4; ++m)
#pragma unroll
                    for (int n = 0; n < 2; ++n) acc[a][b][m][n] = (f32x4){0.f, 0.f, 0.f, 0.f};
        cur = nxt; cA = nA; cB = nB; ++ui;
        if constexpr (ALIGN_EPI) { if (wr == 1) PG8_BAR; }
    }
    PG8_WAIT_V(0);
    if constexpr (!ALIGN_EPI) { if (wr == 0) PG8_BAR; }
    PG8_BAR;
    if constexpr (Epi::AFTER_DRAIN) { E.fused(acc, cur, wr, wc, fr, fq, lds, wid, lane); S.done(cur); }
#undef PG8_SA
#undef PG8_SB
#undef PG8_STAGE
#undef PG8_LDA
#undef PG8_LDB
#undef PG8_MMA
#undef PG8_WAIT_V
#undef PG8_WAIT_L
#undef PG8_BAR
#undef PG8_SCHED
}
}
#define LAS __attribute__((address_space(3)))
typedef unsigned short bf16_t;
typedef short bf16x8 __attribute__((ext_vector_type(8)));
typedef float f32x4 __attribute__((ext_vector_type(4)));
typedef float f32x2 __attribute__((ext_vector_type(2)));
typedef unsigned u32x4 __attribute__((ext_vector_type(4)));
typedef unsigned u32x2 __attribute__((ext_vector_type(2)));
typedef __bf16 bf16x2_t __attribute__((ext_vector_type(2)));

#ifndef MK_N_LAUNCHES
#define MK_N_LAUNCHES 1
#endif

constexpr int NWAVES = 8, NTHR = 512;
constexpr int M = 16384, MS = 128, SEQ = 2048, NB = 8, D = 1024;
constexpr int DI = 2048, NH = 32, HD = 64, NG = 8, HPG = 4, NST = 128, CONVD = 4096, INDIM = 6176, INMAIN = 6144;
constexpr int CW = 2048, FF = 4096, NCHUNK = 16, CH = 128;
constexpr size_t XC_BOFF = (size_t)NB * NH * SEQ * HD, XC_COFF = XC_BOFF + (size_t)NB * NG * SEQ * NST;
constexpr float EPS = 1e-5f;
constexpr int NPHASE = 24;

constexpr size_t O_Y = 0, O_YS = 16777216, O_SSMP = 16908288, O_CONVP = 21102592, O_SSMS = 21299200, O_CONVS = 88408064, O_CMV = 91553792, O_END = 92078080;

constexpr size_t MiB = 1u << 20;
constexpr size_t WS_CTL = 0, CTL_ZERO_BYTES = 1 * MiB;
constexpr size_t WS_WSI = 2 * MiB, WSI_STRIDE = 13 * MiB;
constexpr size_t WS_WSO = 28 * MiB, WSO_STRIDE = 4 * MiB;
constexpr size_t WS_WCI = 36 * MiB, WCI_STRIDE = 8 * MiB;
constexpr size_t WS_WCO = 52 * MiB, WCO_STRIDE = 4 * MiB;
constexpr size_t WS_WUP = 60 * MiB, WUP_STRIDE = 8 * MiB;
constexpr size_t WS_WDN = 92 * MiB, WDN_STRIDE = 8 * MiB;
constexpr size_t WS_X = 124 * MiB;
constexpr size_t WS_XB = 188 * MiB;
constexpr size_t WS_SS = 220 * MiB;
constexpr size_t WS_SSV = 221 * MiB;
constexpr size_t WS_DT = 223 * MiB;
constexpr size_t WS_SSY = 236 * MiB;
constexpr size_t WS_XS = 225 * MiB;
constexpr size_t WS_XSB = WS_XS + 512 * 1024;
constexpr size_t WS_SSS = WS_XSB + 256 * 1024;
constexpr size_t WS_SSVS = WS_SSS + 32 * 1024;
constexpr size_t WS_DTS = WS_SSVS + 64 * 1024;
constexpr size_t WS_ZSS = 226 * MiB;
constexpr size_t WS_XBCS = 227 * MiB;
constexpr size_t WS_YNS = 229 * MiB;
constexpr size_t WS_HS = 230 * MiB;
constexpr size_t WS_US = 231 * MiB;
constexpr size_t WS_GVS = 232 * MiB;
constexpr size_t WS_ZS = 240 * MiB;
constexpr size_t WS_XBC = 304 * MiB;
constexpr size_t WS_HPREV = 432 * MiB;
constexpr size_t WS_YN = 496 * MiB;
constexpr size_t WS_HB = 560 * MiB;
constexpr size_t WS_XC = 688 * MiB;
constexpr size_t WS_END = 816 * MiB;
constexpr int CW_BAR = 4096;

constexpr int LDS_BYTES = 160 * 1024;
constexpr int LDSCTL_OFF = LDS_BYTES - 512;
constexpr int TP = 272;

#define LDS_WAIT() asm volatile("s_waitcnt lgkmcnt(0)" ::: "memory")
#define VM_WAIT() asm volatile("s_waitcnt vmcnt(0)" ::: "memory")
__device__ __forceinline__ unsigned pkbf(float lo, float hi) { f32x2 v = {lo, hi}; bf16x2_t b = __builtin_convertvector(v, bf16x2_t); return __builtin_bit_cast(unsigned, b); }
__device__ __forceinline__ float bf_lo(unsigned w) { return __uint_as_float(w << 16); }
__device__ __forceinline__ float bf_hi(unsigned w) { return __uint_as_float(w & 0xffff0000u); }
__device__ __forceinline__ float bf1(bf16_t h) { return __uint_as_float(((unsigned)h) << 16); }
__device__ __forceinline__ float exp_f(float x) { return __builtin_amdgcn_exp2f(x * 1.4426950408889634f); }
__device__ __forceinline__ float silu_f(float v) { return v * __builtin_amdgcn_rcpf(1.f + __builtin_amdgcn_exp2f(-1.4426950408889634f * v)); }
__device__ __forceinline__ float softplus_f(float x) { return x > 20.f ? x : log1pf(expf(x)); }
__device__ __forceinline__ float wave_sum(float v) {
#pragma unroll
    for (int o = 1; o < 64; o <<= 1) v += __shfl_xor(v, o);
    return v;
}
#define LDS_BARRIER() do { asm volatile("s_waitcnt lgkmcnt(0)" ::: "memory"); __builtin_amdgcn_s_barrier(); asm volatile("" ::: "memory"); } while (0)
__device__ __forceinline__ int lane_id_fresh() { unsigned ones = ~0u; asm volatile("" : "+s"(ones)); return (int)__builtin_amdgcn_mbcnt_hi(ones, __builtin_amdgcn_mbcnt_lo(ones, 0u)); }
__host__ __device__ __forceinline__ int phys256(int c) { return (c & ~255) | (((c >> 5) & 3) << 6) | (((c >> 7) & 1) << 5) | (c & 31); }
__host__ __device__ __forceinline__ int log256(int c) { return (c & ~255) | (((c >> 5) & 1) << 7) | (((c >> 6) & 3) << 5) | (c & 31); }
constexpr int EPISCR_OFF = 132096, EPISCR_PITCH = 144, EPISCR_WAVE = 16 * 144;
__host__ __device__ __forceinline__ size_t frag_off(int row, int k, int K) { return ((size_t)((row >> 4) * (K >> 5) + (k >> 5)) * 64 + (((k >> 3) & 3) * 16 + (row & 15))) * 8 + (k & 7); }
__device__ __forceinline__ float dot4(f32x4 a) { return (a.x * a.x + a.y * a.y) + (a.z * a.z + a.w * a.w); }
__device__ __forceinline__ float row_rstd(const float* ss, int ns4, int row, float inv_n) {
    const f32x4* p = (const f32x4*)(ss + (size_t)row * ns4 * 4); float s = 0.f;
    for (int i = 0; i < ns4; ++i) { const f32x4 v = p[i]; s += (v.x + v.y) + (v.z + v.w); }
    return rsqrtf(s * inv_n + EPS);
}

constexpr int RSTAB_OFF = 131072;
__device__ __forceinline__ int panel_of(int c) { return 8 * (c & 7) + ((c >> 3) & 7); }
__device__ __forceinline__ void fill_rstd_table(LAS unsigned char* lds, const float* SS, int blk, int tid) {
    if (tid < 256) ((LAS float*)(lds + RSTAB_OFF))[tid] = row_rstd(SS, 4, panel_of(blk) * 256 + tid, 1.f / 1024.f);
    asm volatile("s_waitcnt lgkmcnt(0)" ::: "memory");
}

constexpr int RGTAB_OFF = RSTAB_OFF + 1024;
constexpr int RG7_OFF = RGTAB_OFF + 16384;
__device__ __forceinline__ void fill_group_table(LAS unsigned char* lds, const float* SSY, int blk, int tid) {
    if (tid < 256) { const f32x4* p = (const f32x4*)(SSY + ((size_t)panel_of(blk) * 256 + tid) * 32); float s[8];
#pragma unroll
        for (int g = 0; g < 8; ++g) { const f32x4 v = p[g]; s[g] = rsqrtf(((v.x + v.y) + (v.z + v.w)) * (1.f / 256.f) + EPS); }
        LAS float* o = (LAS float*)(lds + RGTAB_OFF) + tid;
#pragma unroll
        for (int i = 0; i < 16; ++i) o[i * 256] = ((i & 1) == 0 && i > 0) ? s[(i >> 1) - 1] / s[i >> 1] : 1.f;
        ((LAS float*)(lds + RG7_OFF))[tid] = s[7]; }
    asm volatile("s_waitcnt lgkmcnt(0)" ::: "memory");
}

#ifndef WT_STORES
#define WT_STORES 1
#endif
__device__ __forceinline__ void st_wt(bf16_t* base, unsigned bytes, size_t off_elems, u32x4 v) {
#if WT_STORES
    __builtin_amdgcn_raw_buffer_store_b128(v, __builtin_amdgcn_make_buffer_rsrc(base, 0, bytes, 0x00020000), (int)(off_elems * 2), 0, 16);
#else
    *(u32x4*)(base + off_elems) = v;
#endif
}

namespace pg8 {
struct EpiResid {
    static constexpr bool PERM = true, AFTER_DRAIN = false, KHOOK = false;
    __device__ __forceinline__ void pre(int tid) const {  }
    bf16_t* XB; float* SS;
    __device__ __forceinline__ void operator()(const f32x4 (&acc)[2][2][4][2], const Unit& u, int wr, int wc, int fr, int fq) const {
        const int row0 = u.pm * BM + wr * 64 + fr, col0 = u.pn * BM + wc * 32 + 8 * fq;
        u32x4 pre2[2][4][2];
#pragma unroll
        for (int ai = 0; ai < 2; ++ai)
#pragma unroll
            for (int m = 0; m < 4; ++m)
#pragma unroll
                for (int bj = 0; bj < 2; ++bj) pre2[ai][m][bj] = *(const u32x4*)(XB + (size_t)(row0 + ai * HALF + m * 16) * 1024 + col0 + bj * HALF);
#pragma unroll
        for (int ai = 0; ai < 2; ++ai) {
#pragma unroll
            for (int m = 0; m < 4; ++m) { const int row = row0 + ai * HALF + m * 16; float ss = 0.f;
#pragma unroll
                for (int bj = 0; bj < 2; ++bj) { const size_t off = (size_t)row * 1024 + col0 + bj * HALF; const u32x4 p = pre2[ai][m][bj];
                    const f32x4 v0 = acc[ai][bj][m][0] + (f32x4){::bf_lo(p.x), ::bf_hi(p.x), ::bf_lo(p.y), ::bf_hi(p.y)}, v1 = acc[ai][bj][m][1] + (f32x4){::bf_lo(p.z), ::bf_hi(p.z), ::bf_lo(p.w), ::bf_hi(p.w)};
                    u32x4 w; w.x = ::pkbf(v0[0], v0[1]); w.y = ::pkbf(v0[2], v0[3]); w.z = ::pkbf(v1[0], v1[1]); w.w = ::pkbf(v1[2], v1[3]);
                    ::st_wt(XB, 16384u * 1024u * 2u, off, w); ss += ::dot4(v0) + ::dot4(v1); }
                ss += __shfl_xor(ss, 16); ss += __shfl_xor(ss, 32);
                if (fq == 0) SS[(size_t)row * 16 + u.pn * 4 + wc] = ss; }
            asm volatile("" ::: "memory");
        }
    }
};
struct EpiResidG {
    static constexpr bool PERM = true, AFTER_DRAIN = false, KHOOK = true;
    bf16_t* XB; float* SS; const LAS float* RG; LAS unsigned char* ldsb; const float* SSY; int blk;
    __device__ __forceinline__ void pre(int tid) const { fill_group_table(ldsb, SSY, blk, tid); }
    __device__ __forceinline__ void khook(f32x4 (&acc)[2][2][4][2], int t, int wr, int fr) const {
        const LAS float* rg = RG + (t >> 1) * 256 + wr * 64 + fr;
#pragma unroll
        for (int ai = 0; ai < 2; ++ai)
#pragma unroll
            for (int m = 0; m < 4; ++m) { const float rt = rg[ai * HALF + m * 16];
#pragma unroll
                for (int bj = 0; bj < 2; ++bj) { acc[ai][bj][m][0] = acc[ai][bj][m][0] * rt; acc[ai][bj][m][1] = acc[ai][bj][m][1] * rt; } }
    }
    __device__ __forceinline__ void operator()(const f32x4 (&acc)[2][2][4][2], const Unit& u, int wr, int wc, int fr, int fq) const {
        const int row0 = u.pm * BM + wr * 64 + fr, col0 = u.pn * BM + wc * 32 + 8 * fq;
        u32x4 pre2[2][4][2];
#pragma unroll
        for (int ai = 0; ai < 2; ++ai)
#pragma unroll
            for (int m = 0; m < 4; ++m)
#pragma unroll
                for (int bj = 0; bj < 2; ++bj) pre2[ai][m][bj] = *(const u32x4*)(XB + (size_t)(row0 + ai * HALF + m * 16) * 1024 + col0 + bj * HALF);
#pragma unroll
        for (int ai = 0; ai < 2; ++ai) {
#pragma unroll
            for (int m = 0; m < 4; ++m) { const int row = row0 + ai * HALF + m * 16; float ss = 0.f; const float s7 = RG[4096 + wr * 64 + fr + ai * HALF + m * 16];
#pragma unroll
                for (int bj = 0; bj < 2; ++bj) { const size_t off = (size_t)row * 1024 + col0 + bj * HALF; const u32x4 p = pre2[ai][m][bj];
                    const f32x4 v0 = acc[ai][bj][m][0] * s7 + (f32x4){::bf_lo(p.x), ::bf_hi(p.x), ::bf_lo(p.y), ::bf_hi(p.y)}, v1 = acc[ai][bj][m][1] * s7 + (f32x4){::bf_lo(p.z), ::bf_hi(p.z), ::bf_lo(p.w), ::bf_hi(p.w)};
                    u32x4 w; w.x = ::pkbf(v0[0], v0[1]); w.y = ::pkbf(v0[2], v0[3]); w.z = ::pkbf(v1[0], v1[1]); w.w = ::pkbf(v1[2], v1[3]);
                    ::st_wt(XB, 16384u * 1024u * 2u, off, w); ss += ::dot4(v0) + ::dot4(v1); }
                ss += __shfl_xor(ss, 16); ss += __shfl_xor(ss, 32);
                if (fq == 0) SS[(size_t)row * 16 + u.pn * 4 + wc] = ss; }
            asm volatile("" ::: "memory");
        }
    }
};
struct EpiSsdIn {
    static constexpr bool PERM = true, AFTER_DRAIN = false, KHOOK = false;
    const LAS float* RS; bf16_t* ZS; bf16_t* XBC; float* convst; LAS unsigned char* scr; LAS unsigned char* ldsb; const float* SSp; int blk;
    __device__ __forceinline__ void pre(int tid) const { fill_rstd_table(ldsb, SSp, blk, tid); }
    __device__ __forceinline__ void operator()(const f32x4 (&acc)[2][2][4][2], const Unit& u, int wr, int wc, int fr, int fq) const {
        const int row0 = u.pm * BM + wr * 64 + fr, col0 = u.pn * BM + wc * 32 + 8 * fq; const bool isz = u.pn < 8;
        LAS unsigned char* sw = scr + (wr * 4 + wc) * EPISCR_WAVE; const int lane = fq * 16 + fr, rrow = lane >> 3, rchunk = lane & 7;
        bf16_t* dst = isz ? ZS : XBC; const int ldd = isz ? 2048 : 4096; const unsigned nbytes = isz ? 16384u * 2048u * 2u : 16384u * 4096u * 2u;
        const size_t gbase = (size_t)(u.pm * BM + wr * 64 + rrow) * ldd + (isz ? u.pn * BM : u.pn * BM - 2048) + wc * 64 + rchunk * 8;
#pragma unroll
        for (int ai = 0; ai < 2; ++ai)
#pragma unroll
            for (int m = 0; m < 4; ++m) { const int row = row0 + ai * HALF + m * 16; const float rs = RS[wr * 64 + fr + ai * HALF + m * 16];
#pragma unroll
                for (int bj = 0; bj < 2; ++bj) { const int c = col0 + bj * HALF; f32x4 v0 = acc[ai][bj][m][0] * rs, v1 = acc[ai][bj][m][1] * rs; u32x4 w;
                    if (isz) { w.x = ::pkbf(::silu_f(v0[0]), ::silu_f(v0[1])); w.y = ::pkbf(::silu_f(v0[2]), ::silu_f(v0[3])); w.z = ::pkbf(::silu_f(v1[0]), ::silu_f(v1[1])); w.w = ::pkbf(::silu_f(v1[2]), ::silu_f(v1[3])); }
                    else { w.x = ::pkbf(v0[0], v0[1]); w.y = ::pkbf(v0[2], v0[3]); w.z = ::pkbf(v1[0], v1[1]); w.w = ::pkbf(v1[2], v1[3]);
                        const int t = row & 2047;
                        if (t >= 2045) { float* o = convst + ((size_t)(row >> 11) * 3 + (t - 2045)) * 4096 + c - 2048; *(f32x4*)o = v0; *(f32x4*)(o + 4) = v1; } }
                    *(LAS u32x4*)(sw + fr * EPISCR_PITCH + bj * 64 + fq * 16) = w; }
#pragma unroll
                for (int hh = 0; hh < 2; ++hh) { const u32x4 w = *(const LAS u32x4*)(sw + (hh * 8 + rrow) * EPISCR_PITCH + rchunk * 16);
                    ::st_wt(dst, nbytes, gbase + (size_t)(ai * HALF + m * 16 + hh * 8) * ldd, w); } }
    }
};
struct EpiMlpUp {
    static constexpr bool PERM = true, AFTER_DRAIN = false, KHOOK = false;
    const LAS float* RS; bf16_t* HB; LAS unsigned char* scr; LAS unsigned char* ldsb; const float* SSp; int blk; int mode = 0;
    __device__ __forceinline__ void pre(int tid) const { fill_rstd_table(ldsb, SSp, blk, tid); }
    __device__ __forceinline__ void operator()(const f32x4 (&acc)[2][2][4][2], const Unit& u, int wr, int wc, int fr, int fq) const {
        LAS unsigned char* sw = scr + (wr * 4 + wc) * EPISCR_WAVE; const int lane = fq * 16 + fr;
        const int rrow = lane >> 3, rchunk = lane & 7;
        const size_t gbase = ((size_t)(u.pm * 64 + u.pn * 4 + wc) * BM + wr * 64 + rrow) * 64 + rchunk * 8;
#pragma unroll
        for (int ai = 0; ai < 2; ++ai)
#pragma unroll
            for (int m = 0; m < 4; ++m) { const float rs = RS[wr * 64 + fr + ai * HALF + m * 16];
#pragma unroll
                for (int bj = 0; bj < 2; ++bj) { f32x4 v0 = acc[ai][bj][m][0] * rs, v1 = acc[ai][bj][m][1] * rs;
#pragma unroll
                    for (int e = 0; e < 4; ++e) { const float a = fmaxf(v0[e], 0.f), b = fmaxf(v1[e], 0.f); v0[e] = a * a; v1[e] = b * b; }
                    u32x4 w; w.x = ::pkbf(v0[0], v0[1]); w.y = ::pkbf(v0[2], v0[3]); w.z = ::pkbf(v1[0], v1[1]); w.w = ::pkbf(v1[2], v1[3]);
                    *(LAS u32x4*)(sw + fr * EPISCR_PITCH + bj * 64 + fq * 16) = w; }
#pragma unroll
                for (int hh = 0; hh < 2; ++hh) { const u32x4 w = *(const LAS u32x4*)(sw + (hh * 8 + rrow) * EPISCR_PITCH + rchunk * 16);
                    if (mode == 0) ::st_wt(HB, 16384u * 4096u * 2u, gbase + (size_t)(ai * HALF + m * 16 + hh * 8) * 64, w); else if (mode == 2) *(u32x4*)(HB + gbase + (size_t)(ai * HALF + m * 16 + hh * 8) * 64) = w; else asm volatile("" :: "v"(w.x), "v"(w.y), "v"(w.z), "v"(w.w)); } }
    }
};
struct EpiCmIn {
    static constexpr bool PERM = true, AFTER_DRAIN = false, KHOOK = false;
    const LAS float* RS; const float* bias; bf16_t* U; bf16_t* GV; float* SSV; LAS unsigned char* scr; LAS unsigned char* ldsb; const float* SSp; int blk;
    __device__ __forceinline__ void pre(int tid) const { fill_rstd_table(ldsb, SSp, blk, tid); }
    __device__ __forceinline__ void operator()(const f32x4 (&acc)[2][2][4][2], const Unit& u, int wr, int wc, int fr, int fq) const {
        const int row0 = u.pm * BM + wr * 64 + fr, col0 = u.pn * BM + wc * 32 + 8 * fq; const bool isu = u.pn < 8;
        LAS unsigned char* sw = scr + (wr * 4 + wc) * EPISCR_WAVE; const int lane = fq * 16 + fr, rrow = lane >> 3, rchunk = lane & 7;
        bf16_t* dst = isu ? U : GV;
        const size_t gbase = isu ? ((size_t)(u.pm * 32 + u.pn * 4 + wc) * BM + wr * 64 + rrow) * 64 + rchunk * 8
                                 : ((size_t)(((2 * u.pm) * 8 + (u.pn - 8)) * 2 + (wc >> 1)) * 128 + wr * 64 + rrow) * 128 + (wc & 1) * 64 + rchunk * 8;
        const size_t aist = isu ? (size_t)HALF * 64 : (size_t)8 * 2 * 128 * 128; const int rst = isu ? 64 : 128;
        f32x4 bv[2][2];
#pragma unroll
        for (int bj = 0; bj < 2; ++bj) { bv[bj][0] = *(const f32x4*)(bias + col0 + bj * HALF); bv[bj][1] = *(const f32x4*)(bias + col0 + bj * HALF + 4); }
#pragma unroll
        for (int ai = 0; ai < 2; ++ai)
#pragma unroll
            for (int m = 0; m < 4; ++m) { const int row = row0 + ai * HALF + m * 16; const float rs = RS[wr * 64 + fr + ai * HALF + m * 16]; float ss = 0.f;
#pragma unroll
                for (int bj = 0; bj < 2; ++bj) { f32x4 v0 = acc[ai][bj][m][0] * rs + bv[bj][0], v1 = acc[ai][bj][m][1] * rs + bv[bj][1];
                    const f32x2 a = gelu_pk((f32x2){v0[0], v0[1]}), b = gelu_pk((f32x2){v0[2], v0[3]}), c = gelu_pk((f32x2){v1[0], v1[1]}), d = gelu_pk((f32x2){v1[2], v1[3]});
                    u32x4 w; w.x = ::pkbf(a.x, a.y); w.y = ::pkbf(b.x, b.y); w.z = ::pkbf(c.x, c.y); w.w = ::pkbf(d.x, d.y);
                    *(LAS u32x4*)(sw + fr * EPISCR_PITCH + bj * 64 + fq * 16) = w;
                    if (!isu) ss += (a.x * a.x + a.y * a.y) + (b.x * b.x + b.y * b.y) + (c.x * c.x + c.y * c.y) + (d.x * d.x + d.y * d.y); }
#pragma unroll
                for (int hh = 0; hh < 2; ++hh) { const u32x4 w = *(const LAS u32x4*)(sw + (hh * 8 + rrow) * EPISCR_PITCH + rchunk * 16);
                    ::st_wt(dst, 16384u * 2048u * 2u, gbase + ai * aist + (size_t)(m * 16 + hh * 8) * rst, w); }
                if (!isu) { ss += __shfl_xor(ss, 16); ss += __shfl_xor(ss, 32); if (fq == 0) SSV[(size_t)row * 32 + (u.pn - 8) * 4 + wc] = ss; } }
    }
};
struct EpiNull {
    static constexpr bool PERM = true, AFTER_DRAIN = false, KHOOK = false;
    __device__ __forceinline__ void pre(int tid) const {  }
    __device__ __forceinline__ void operator()(const f32x4 (&acc)[2][2][4][2], const Unit& u, int wr, int wc, int fr, int fq) const {
#pragma unroll
        for (int ai = 0; ai < 2; ++ai)
#pragma unroll
            for (int bj = 0; bj < 2; ++bj)
#pragma unroll
                for (int m = 0; m < 4; ++m)
#pragma unroll
                    for (int n = 0; n < 2; ++n) asm volatile("" :: "v"(acc[ai][bj][m][n]));
    }
};
}

template <int MT, int STEPS, bool AFRAG> __device__ __forceinline__ f32x4 block_gemm_ks(int wave, int lane, const bf16_t* A, int lda, int row_base, const bf16_t* Wt, int K, int col0, LAS float* red) {
    const int fr = lane & 15, fq = lane >> 4, ksl = K >> 3, nsteps = ksl >> 5;
    const bf16x8* ap = AFRAG ? (const bf16x8*)A + ((size_t)(row_base >> 4) * (K >> 5) + wave * (ksl >> 5)) * 64 + lane
                             : (const bf16x8*)(A + (size_t)(row_base + fr) * lda + wave * ksl + 8 * fq);
    const bf16x8* bp = (const bf16x8*)(Wt + (size_t)(col0 + fr) * K + wave * ksl + 8 * fq);
    const size_t mstride = AFRAG ? (size_t)(K >> 5) * 64 : (size_t)16 * lda / 8; const int sstride = AFRAG ? 64 : 4;
    f32x4 acc[MT];
#pragma unroll
    for (int m = 0; m < MT; ++m) acc[m] = (f32x4){0.f, 0.f, 0.f, 0.f};
    __syncthreads();
#pragma unroll 1
    for (int s0 = 0; s0 < nsteps; s0 += STEPS) {
        bf16x8 bfr[STEPS], afr[MT][STEPS];
#pragma unroll
        for (int s = 0; s < STEPS; ++s) { bfr[s] = bp[4 * (s0 + s)];
#pragma unroll
            for (int m = 0; m < MT; ++m) afr[m][s] = ap[m * mstride + sstride * (s0 + s)]; }
#pragma unroll
        for (int s = 0; s < STEPS; ++s)
#pragma unroll
            for (int m = 0; m < MT; ++m) acc[m] = __builtin_amdgcn_mfma_f32_16x16x32_bf16(bfr[s], afr[m][s], acc[m], 0, 0, 0);
    }
#pragma unroll
    for (int m = 0; m < MT; ++m) *(LAS f32x4*)(red + ((wave * MT + m) * 64 + lane) * 4) = acc[m];
    __syncthreads();
    f32x4 v = (f32x4){0.f, 0.f, 0.f, 0.f};
    if (wave < MT) {
#pragma unroll
        for (int w2 = 0; w2 < 8; ++w2) v = v + *(const LAS f32x4*)(red + ((w2 * MT + wave) * 64 + lane) * 4);
    }
    return v;
}

__device__ __forceinline__ void block_gemm_ks2(int wave, int lane, const bf16_t* A, const bf16_t* Wt, int K, int col0, LAS float* red, f32x4& o0, f32x4& o1) {
    const int fr = lane & 15, fq = lane >> 4, ksl = K >> 3, nsteps = ksl >> 5;
    const bf16x8* ap = (const bf16x8*)A + ((size_t)wave * (ksl >> 5)) * 64 + lane;
    const bf16x8* bp0 = (const bf16x8*)(Wt + (size_t)(col0 + fr) * K + wave * ksl + 8 * fq); const bf16x8* bp1 = (const bf16x8*)(Wt + (size_t)(col0 + 16 + fr) * K + wave * ksl + 8 * fq);
    const size_t mstride = (size_t)(K >> 5) * 64;
    f32x4 acc[8][2];
#pragma unroll
    for (int m = 0; m < 8; ++m) { acc[m][0] = (f32x4){0.f, 0.f, 0.f, 0.f}; acc[m][1] = acc[m][0]; }
    __syncthreads();
#pragma unroll 1
    for (int s0 = 0; s0 < nsteps; s0 += 2) {
        bf16x8 b0[2], b1[2], afr[8][2];
#pragma unroll
        for (int s = 0; s < 2; ++s) { b0[s] = bp0[4 * (s0 + s)]; b1[s] = bp1[4 * (s0 + s)];
#pragma unroll
            for (int m = 0; m < 8; ++m) afr[m][s] = ap[m * mstride + 64 * (s0 + s)]; }
#pragma unroll
        for (int s = 0; s < 2; ++s)
#pragma unroll
            for (int m = 0; m < 8; ++m) { acc[m][0] = __builtin_amdgcn_mfma_f32_16x16x32_bf16(b0[s], afr[m][s], acc[m][0], 0, 0, 0); acc[m][1] = __builtin_amdgcn_mfma_f32_16x16x32_bf16(b1[s], afr[m][s], acc[m][1], 0, 0, 0); }
    }
#pragma unroll
    for (int m = 0; m < 8; ++m) { *(LAS f32x4*)(red + (((wave * 8 + m) * 2 + 0) * 64 + lane) * 4) = acc[m][0]; *(LAS f32x4*)(red + (((wave * 8 + m) * 2 + 1) * 64 + lane) * 4) = acc[m][1]; }
    __syncthreads();
    o0 = (f32x4){0.f, 0.f, 0.f, 0.f}; o1 = o0;
#pragma unroll
    for (int w2 = 0; w2 < 8; ++w2) { o0 = o0 + *(const LAS f32x4*)(red + (((w2 * 8 + wave) * 2 + 0) * 64 + lane) * 4); o1 = o1 + *(const LAS f32x4*)(red + (((w2 * 8 + wave) * 2 + 1) * 64 + lane) * 4); }
}

#define PHASE_CTX(c0) Ctx c = (c0); c.lane = lane_id_fresh(); c.tid = c.wave * 64 + c.lane
struct Ctx {
    const float* in[23]; float* out; unsigned char* ws;
    LAS unsigned char* lds; int tid, lane, wave, blk, G;
};

struct TrItem { const float* W; bf16_t* WT; const float* gk; int K, N, k0, n0, perm; };
__device__ __forceinline__ TrItem tr_decode(const Ctx& c, int it) {
    constexpr int I_SI = 16 * 193, I_SO = 32 * 32, I_CI = 16 * 128, I_CO = 32 * 32, I_UP = 16 * 128, I_DN = 64 * 32;
    constexpr int NITEMS_BEFORE_DN = 2 * I_SI + 2 * I_SO + 2 * I_CI + 2 * I_CO + 4 * I_UP;
    constexpr int NITEMS_BEFORE_CO = 2 * I_SI + 2 * I_SO + 2 * I_CI;
    TrItem t; int r = it, j;
    if (r < 2 * I_SI) { j = r / I_SI; r -= j * I_SI; t.W = c.in[7] + (size_t)j * 1024 * INDIM; t.K = 1024; t.N = INDIM; t.WT = (bf16_t*)(c.ws + WS_WSI + j * WSI_STRIDE); t.gk = c.in[4] + (2 * j) * 1024; }
    else if ((r -= 2 * I_SI) < 2 * I_SO) { j = r / I_SO; r -= j * I_SO; t.W = c.in[14] + (size_t)j * 2048 * 1024; t.K = 2048; t.N = 1024; t.WT = (bf16_t*)(c.ws + WS_WSO + j * WSO_STRIDE); t.gk = c.in[13] + j * 2048; }
    else if ((r -= 2 * I_SO) < 2 * I_CI) { j = r / I_CI; r -= j * I_CI; t.W = c.in[15] + (size_t)j * 1024 * 4096; t.K = 1024; t.N = 4096; t.WT = (bf16_t*)(c.ws + WS_WCI + j * WCI_STRIDE); t.gk = c.in[4] + (2 * j + 1) * 1024; }
    else if ((r -= 2 * I_CI) < 2 * I_CO) { j = r / I_CO; r -= j * I_CO; t.W = c.in[20] + (size_t)j * 2048 * 1024; t.K = 2048; t.N = 1024; t.WT = (bf16_t*)(c.ws + WS_WCO + j * WCO_STRIDE); t.gk = nullptr; }
    else if ((r -= 2 * I_CO) < 4 * I_UP) { j = r / I_UP; r -= j * I_UP; t.W = c.in[21] + (size_t)j * 1024 * 4096; t.K = 1024; t.N = 4096; t.WT = (bf16_t*)(c.ws + WS_WUP + j * WUP_STRIDE); t.gk = c.in[5] + j * 1024; }
    else { r -= 4 * I_UP; j = r / I_DN; r -= j * I_DN; t.W = c.in[22] + (size_t)j * 4096 * 1024; t.K = 4096; t.N = 1024; t.WT = (bf16_t*)(c.ws + WS_WDN + j * WDN_STRIDE); t.gk = nullptr; }
    const int nblk = t.N / 32; t.k0 = 64 * (r / nblk); t.n0 = 32 * (r % nblk); t.perm = (it >= NITEMS_BEFORE_DN || (it >= NITEMS_BEFORE_CO && it < NITEMS_BEFORE_CO + 2 * I_CO)) ? 1 : 0; return t;
}
__device__ __forceinline__ void tr_load(const TrItem& t, int lane, f32x4 (&v)[8], f32x4 (&gv)[2]) {
    const float* p = t.W + t.n0 + 4 * (lane & 7);
#pragma unroll
    for (int i = 0; i < 8; ++i) { const int kp = t.k0 + (lane >> 3) + 8 * i; v[i] = *(const f32x4*)(p + (size_t)(t.perm ? log256(kp) : kp) * t.N); }
    if (t.gk) { gv[0] = *(const f32x4*)(t.gk + t.k0 + 8 * (lane & 7)); gv[1] = *(const f32x4*)(t.gk + t.k0 + 8 * (lane & 7) + 4); }
    else { gv[0] = (f32x4){1.f, 1.f, 1.f, 1.f}; gv[1] = gv[0]; }
}
__device__ __forceinline__ void row_to_bf16_ss(const float* xrow, bf16_t* orow, float* ssrow, int nslots, int lane, int frag_row = -1) {
    const f32x4* xr = (const f32x4*)xrow + lane; float s = 0.f; f32x4 v[4];
#pragma unroll
    for (int j = 0; j < 4; ++j) { v[j] = xr[64 * j]; s += dot4(v[j]); }
    s = wave_sum(s);
#pragma unroll
    for (int j = 0; j < 4; ++j) { u32x2 w; w.x = pkbf(v[j].x, v[j].y); w.y = pkbf(v[j].z, v[j].w); const int col = 4 * lane + 256 * j; *(u32x2*)(orow + (frag_row >= 0 ? frag_off(frag_row, col, 1024) : (size_t)col)) = w; }
    for (int i = lane; i < nslots; i += 64) ssrow[i] = (i == 0) ? s : 0.f;
}

__device__ __forceinline__ void phase_prologue(const Ctx& c0) {
    PHASE_CTX(c0);
    LAS float* scr = (LAS float*)(c.lds + c.wave * 16384);
    const int gw = c.blk * NWAVES + c.wave, NGW = c.G * NWAVES;
    constexpr int NITEMS = 2 * (16 * 193) + 2 * (32 * 32) + 2 * (16 * 128) + 2 * (32 * 32) + 4 * (16 * 128) + 4 * (64 * 32);
    for (int m = gw; m < M + MS; m += NGW) {
        if (m < M) row_to_bf16_ss(c.in[0] + (size_t)m * D, (bf16_t*)(c.ws + WS_XB) + (size_t)m * D, (float*)(c.ws + WS_SS) + (size_t)m * 16, 16, c.lane);
        else { const int r = m - M; row_to_bf16_ss(c.in[1] + (size_t)r * D, (bf16_t*)(c.ws + WS_XSB), (float*)(c.ws + WS_SSS) + (size_t)r * 64, 64, c.lane, r); }
    }
    int it = gw; asm volatile("" : "+s"(it));
    if (it < NITEMS) {
        TrItem cur = tr_decode(c, it); f32x4 v[8], gv[2]; tr_load(cur, c.lane, v, gv);
#pragma unroll 1
        for (;;) {
#pragma unroll
            for (int i = 0; i < 8; ++i) { LAS float* s = scr + ((c.lane >> 3) + 8 * i) * 33 + 4 * (c.lane & 7); s[0] = v[i].x; s[1] = v[i].y; s[2] = v[i].z; s[3] = v[i].w; }
            const f32x4 g0 = gv[0], g1 = gv[1]; const TrItem t = cur;
            LDS_WAIT(); asm volatile("" ::: "memory");
            const int nxt = it + NGW; const bool more = nxt < NITEMS;
            if (more) { cur = tr_decode(c, nxt); tr_load(cur, c.lane, v, gv); }
            const int cc = c.lane & 7;
#pragma unroll
            for (int jn = 0; jn < 4; ++jn) { const int n = (c.lane >> 3) + 8 * jn; const LAS float* s = scr + (8 * cc) * 33 + n;
                u32x4 o; o.x = pkbf(s[0 * 33] * g0.x, s[1 * 33] * g0.y); o.y = pkbf(s[2 * 33] * g0.z, s[3 * 33] * g0.w); o.z = pkbf(s[4 * 33] * g1.x, s[5 * 33] * g1.y); o.w = pkbf(s[6 * 33] * g1.z, s[7 * 33] * g1.w);
                *(u32x4*)(t.WT + (size_t)(t.n0 + n) * t.K + t.k0 + 8 * cc) = o; }
            LDS_WAIT(); asm volatile("" ::: "memory");
            if (!more) break;
            it = nxt;
        }
    }
}

__device__ __forceinline__ void phase_conv(const Ctx& c0, int j) {
    PHASE_CTX(c0);
    const bf16_t* XBC = (const bf16_t*)(c.ws + WS_XBC); bf16_t* XC = (bf16_t*)(c.ws + WS_XC);
    const float* cw = c.in[8] + (size_t)j * 4 * CONVD; const float* cb = c.in[9] + (size_t)j * CONVD;
    LAS float* xs = (LAS float*)c.lds;
    LAS float* yb = xs + 512;
    LAS float* hd = xs + 768;
    LAS float* zb = xs + 784;
    const int w = c.wave;
    const float* XBCS = (const float*)(c.ws + WS_XBCS); const float* DTS = (const float*)(c.ws + WS_DTS); const float* ZSS = (const float*)(c.ws + WS_ZSS);
    bf16_t* YNS = (bf16_t*)(c.ws + WS_YNS);
    const float* cst_in = c.in[3] + (size_t)j * MS * 3 * CONVD; float* cst_out = c.out + O_CONVS + (size_t)j * MS * 3 * CONVD;
    const float* st_in = c.in[2] + (size_t)j * MS * NH * HD * NST; float* st_out = c.out + O_SSMS + (size_t)j * MS * NH * HD * NST;
#define SAMPLE_CONV(sit) do { const int sb_ = (sit) >> 3, g_ = (sit) & 7, t_ = c.tid; \
        const int ch_ = t_ < 256 ? g_ * 256 + t_ : (t_ < 384 ? 2048 + g_ * 128 + (t_ - 256) : 3072 + g_ * 128 + (t_ - 384)); \
        const float* ci_ = cst_in + (size_t)sb_ * 3 * CONVD + ch_; const float c0_ = ci_[0], c1_ = ci_[CONVD], c2_ = ci_[2 * CONVD], xn_ = XBCS[(size_t)sb_ * CONVD + ch_]; \
        xs[t_] = silu_f(cb[ch_] + cw[ch_] * c0_ + cw[CONVD + ch_] * c1_ + cw[2 * CONVD + ch_] * c2_ + cw[3 * CONVD + ch_] * xn_); \
        float* co_ = cst_out + (size_t)sb_ * 3 * CONVD + ch_; co_[0] = c1_; co_[CONVD] = c2_; co_[2 * CONVD] = xn_; \
        if (t_ < 256) zb[t_] = ZSS[(size_t)sb_ * DI + g_ * 256 + t_]; \
        if (t_ < 4) { const int h_ = 4 * g_ + t_; const float dt_ = DTS[sb_ * 32 + h_]; hd[t_] = dt_; hd[4 + t_] = expf(dt_ * -expf(c.in[11][j * NH + h_])); hd[8 + t_] = c.in[12][j * NH + h_]; } } while (0)
    for (int item = c.blk; item < NB * 32; item += c.G) {
        const int bb = item >> 5, rb = item & 31, ch = 8 * c.tid;
        const bf16_t* src = XBC + ((size_t)bb * SEQ + rb * 64) * CONVD + phys256(ch);
        const int xrs = ch < 2048 ? 64 : 128;
        bf16_t* dstp = XC + (ch < 2048 ? ((size_t)(bb * NH + (ch >> 6)) * SEQ + rb * 64) * 64 + (ch & 63)
                                     : (ch < 3072 ? XC_BOFF : XC_COFF) + ((size_t)(bb * NG + (((ch - 2048) & 1023) >> 7)) * SEQ + rb * 64) * 128 + (ch & 127));
        f32x4 wv[4][2], bia[2], win[3][2];
#pragma unroll
        for (int k = 0; k < 4; ++k) { wv[k][0] = *(const f32x4*)(cw + k * CONVD + ch); wv[k][1] = *(const f32x4*)(cw + k * CONVD + ch + 4); }
        bia[0] = *(const f32x4*)(cb + ch); bia[1] = *(const f32x4*)(cb + ch + 4);
#pragma unroll
        for (int i = 0; i < 3; ++i) { u32x4 r = (u32x4){0u, 0u, 0u, 0u}; if (rb > 0) r = *(const u32x4*)(src + (ptrdiff_t)(i - 3) * CONVD);
            win[i][0] = (f32x4){bf_lo(r.x), bf_hi(r.x), bf_lo(r.y), bf_hi(r.y)}; win[i][1] = (f32x4){bf_lo(r.z), bf_hi(r.z), bf_lo(r.w), bf_hi(r.w)}; }
        SAMPLE_CONV(item * 4);
        f32x4 st[4];
        { const int sit0 = item * 4, ssb0 = sit0 >> 3, sh0 = 4 * (sit0 & 7); const size_t sb0 = (((size_t)ssb0 * NH + sh0) * HD + 8 * w + (c.lane >> 5)) * NST + 4 * (c.lane & 31);
#pragma unroll
          for (int i = 0; i < 4; ++i) st[i] = *(const f32x4*)(st_in + sb0 + (size_t)(2 * i) * NST); }
        u32x4 rawn[4];
#pragma unroll
        for (int i = 0; i < 4; ++i) rawn[i] = *(const u32x4*)(src + (size_t)i * CONVD);
        __syncthreads();
#pragma unroll 1
        for (int ck = 0; ck < 16; ++ck) {
            u32x4 raw[4];
#pragma unroll
            for (int i = 0; i < 4; ++i) raw[i] = rawn[i];
            if (ck + 1 < 16) {
#pragma unroll
                for (int i = 0; i < 4; ++i) rawn[i] = *(const u32x4*)(src + (size_t)(4 * (ck + 1) + i) * CONVD); }
            { const int sit = item * 4 + (ck >> 2), ssb = sit >> 3, sg = sit & 7, r = ck & 3, sh = 4 * sg + r, half = c.lane >> 5, nq = c.lane & 31;
              const size_t sbase = (((size_t)ssb * NH + sh) * HD + 8 * w + half) * NST + 4 * nq;
              const float dt = hd[r], dA = hd[4 + r], Dsh = hd[8 + r];
              const f32x4 B4 = *(const LAS f32x4*)(xs + 256 + 4 * nq), C4 = *(const LAS f32x4*)(xs + 384 + 4 * nq);
#pragma unroll
              for (int i = 0; i < 4; ++i) { const int p = 8 * w + 2 * i + half; const float xp = xs[r * 64 + p];
                  const f32x4 hn = st[i] * dA + B4 * (dt * xp);
                  *(f32x4*)(st_out + sbase + (size_t)(2 * i) * NST) = hn;
                  float part = (C4.x * hn.x + C4.y * hn.y) + (C4.z * hn.z + C4.w * hn.w);
                  part += __shfl_xor(part, 1); part += __shfl_xor(part, 2); part += __shfl_xor(part, 4); part += __shfl_xor(part, 8); part += __shfl_xor(part, 16);
                  if (nq == 0) yb[r * 64 + p] = (part + Dsh * xp) * zb[r * 64 + p]; }
              if (ck + 1 < 16) { const int sit1 = item * 4 + ((ck + 1) >> 2), ssb1 = sit1 >> 3, sh1 = 4 * (sit1 & 7) + ((ck + 1) & 3); const size_t sb1 = (((size_t)ssb1 * NH + sh1) * HD + 8 * w + half) * NST + 4 * nq;
#pragma unroll
                  for (int i = 0; i < 4; ++i) st[i] = *(const f32x4*)(st_in + sb1 + (size_t)(2 * i) * NST); } }
#pragma unroll
            for (int i = 0; i < 4; ++i) { const u32x4 r = raw[i];
                const f32x4 c0v = (f32x4){bf_lo(r.x), bf_hi(r.x), bf_lo(r.y), bf_hi(r.y)}, c1v = (f32x4){bf_lo(r.z), bf_hi(r.z), bf_lo(r.w), bf_hi(r.w)};
                f32x4 o0 = bia[0] + wv[0][0] * win[0][0] + wv[1][0] * win[1][0] + wv[2][0] * win[2][0] + wv[3][0] * c0v;
                f32x4 o1 = bia[1] + wv[0][1] * win[0][1] + wv[1][1] * win[1][1] + wv[2][1] * win[2][1] + wv[3][1] * c1v;
                win[0][0] = win[1][0]; win[0][1] = win[1][1]; win[1][0] = win[2][0]; win[1][1] = win[2][1]; win[2][0] = c0v; win[2][1] = c1v;
                u32x4 q; q.x = pkbf(silu_f(o0[0]), silu_f(o0[1])); q.y = pkbf(silu_f(o0[2]), silu_f(o0[3])); q.z = pkbf(silu_f(o1[0]), silu_f(o1[1])); q.w = pkbf(silu_f(o1[2]), silu_f(o1[3]));
                *(u32x4*)(dstp + (size_t)(4 * ck + i) * xrs) = q; }
            LDS_BARRIER();
            if ((ck & 3) == 3) {
                const int sit = item * 4 + (ck >> 2), ssb = sit >> 3, sg = sit & 7;
                const f32x4 yv4 = *(const LAS f32x4*)(yb + 4 * c.lane); const float tot = wave_sum(dot4(yv4)); const float rs = rsqrtf(tot * (1.f / 256.f) + EPS);
                if (c.lane < 16) { const int i2 = w * 32 + 2 * c.lane; *(unsigned*)(YNS + frag_off(ssb, sg * 256 + i2, DI)) = pkbf(yb[i2] * rs, yb[i2 + 1] * rs); }
                if (ck + 1 < 16) SAMPLE_CONV(sit + 1);
            }
            LDS_BARRIER();
        }
    }
#undef SAMPLE_CONV
}

__device__ __forceinline__ u32x4 tr8_col(const u32x4 (&raw)[8], int jj) {
    unsigned e[8];
#pragma unroll
    for (int i = 0; i < 8; ++i) { const unsigned wd = (jj >> 1) == 0 ? raw[i].x : ((jj >> 1) == 1 ? raw[i].y : ((jj >> 1) == 2 ? raw[i].z : raw[i].w)); e[i] = (jj & 1) ? (wd >> 16) : (wd & 0xffffu); }
    u32x4 o; o.x = e[0] | (e[1] << 16); o.y = e[2] | (e[3] << 16); o.z = e[4] | (e[5] << 16); o.w = e[6] | (e[7] << 16); return o;
}

typedef short v4i16_t __attribute__((ext_vector_type(4)));
__device__ __forceinline__ bf16x8 lds_tr_frag(const LAS unsigned char* tile, int pitch, int k0, int n0, int lane) {
    const int g = lane >> 4, q = (lane & 15) >> 2, p = lane & 3;
    const LAS unsigned char* a = tile + (k0 + 8 * g + q) * pitch + (n0 + 4 * p) * 2;
    const v4i16_t lo = __builtin_amdgcn_ds_read_tr16_b64_v4i16((LAS v4i16_t*)a);
    const v4i16_t hi = __builtin_amdgcn_ds_read_tr16_b64_v4i16((LAS v4i16_t*)(a + 4 * pitch));
    return (bf16x8){lo[0], lo[1], lo[2], lo[3], hi[0], hi[1], hi[2], hi[3]};
}
__device__ __forceinline__ void phase_ssd_scan(const Ctx& c0, int j) {
    PHASE_CTX(c0);
    const bf16_t* XC = (const bf16_t*)(c.ws + WS_XC); const float* DT = (const float*)(c.ws + WS_DT); const bf16_t* ZS = (const bf16_t*)(c.ws + WS_ZS);
    bf16_t* YN = (bf16_t*)(c.ws + WS_YN); float* SSY = (float*)(c.ws + WS_SSY);
    constexpr int XP = 144;
    LAS unsigned char* RC = c.lds;
    LAS unsigned char* RB = c.lds + 34816;
    LAS unsigned char* RX = c.lds + 69632;
    LAS unsigned char* RX2 = c.lds + 88064;
    LAS unsigned char* RH = c.lds + 106496;
    LAS float* scl = (LAS float*)(c.lds + 123904);
    const int w = c.wave;
    const int rt = (w < 4) ? w : 11 - w;
    for (int item_ = c.blk; item_ < NB * NH; item_ += c.G) {
        const int item = ((item_ & 7) << 5) | (item_ >> 3);
        const int bb = item >> 5, h = item & 31, g = h >> 2;
        const float Ah = -expf(c.in[11][j * NH + h]), Dh = c.in[12][j * NH + h];
        f32x4 hs[4];
#pragma unroll
        for (int t = 0; t < 4; ++t) hs[t] = (f32x4){0.f, 0.f, 0.f, 0.f};
        const int pt = w & 3, nt0 = 4 * (w >> 2);
        u32x4 ncp[4], nbp[4], nxp[4]; u32x2 nzz[4]; float nd0 = 0.f, nd1 = 0.f;
#define STAGE_LOADS(ck) do { \
            _Pragma("unroll") for (int i = 0; i < 4; ++i) { const int pc_ = c.tid + 512 * i, rw_ = pc_ >> 4, cc_ = pc_ & 15; \
                ncp[i] = *(const u32x4*)(XC + XC_COFF + ((size_t)(bb * NG + g) * SEQ + (ck) * CH + rw_) * 128 + cc_ * 8); nbp[i] = *(const u32x4*)(XC + XC_BOFF + ((size_t)(bb * NG + g) * SEQ + (ck) * CH + rw_) * 128 + cc_ * 8); } \
            if (w < 4) { _Pragma("unroll") for (int i = 0; i < 4; ++i) { const int px_ = c.tid + 256 * i, rw_ = px_ >> 3, cc_ = px_ & 7; nxp[i] = *(const u32x4*)(XC + ((size_t)(bb * NH + h) * SEQ + (ck) * CH + rw_) * 64 + cc_ * 8); } } \
            { const int q_ = 16 * rt + (c.lane & 15); _Pragma("unroll") for (int p4 = 0; p4 < 4; ++p4) nzz[p4] = *(const u32x2*)(ZS + ((size_t)bb * SEQ + (ck) * CH + q_) * DI + phys256(h * 64 + 16 * p4 + 4 * (c.lane >> 4))); } \
            if (w == 1) { const float* dp_ = DT + ((size_t)bb * SEQ + (ck) * CH + 2 * c.lane) * 32 + h; nd0 = dp_[0]; nd1 = dp_[32]; } } while (0)
#define SSD_SCALE(ck) do { const int s0 = 2 * c.lane; const float d0 = nd0, d1 = nd1; const float a0 = d0 * Ah, a1 = d1 * Ah; float run = a0 + a1; \
            _Pragma("unroll") for (int o = 1; o < 64; o <<= 1) { const float t_ = __shfl_up(run, o); if (c.lane >= o) run += t_; } \
            const float tot = __shfl(run, 63); const float ac1 = run, ac0 = run - a1; \
            LAS float* sb_ = scl + ((ck) & 1) * 400; sb_[s0] = ac0; sb_[s0 + 1] = ac1; sb_[128 + s0] = d0; sb_[128 + s0 + 1] = d1; \
            sb_[256 + s0] = d0 * exp_f(tot - ac0); sb_[256 + s0 + 1] = d1 * exp_f(tot - ac1); if (c.lane == 0) sb_[384] = exp_f(tot); } while (0)
        STAGE_LOADS(0);
        if (w == 1) SSD_SCALE(0);
        __syncthreads();
        for (int ck = 0; ck < NCHUNK; ++ck) {
            { int lz_ = c.lane; asm volatile("" : "+v"(lz_)); c.lane = lz_; c.tid = w * 64 + lz_; }
            const int fr = c.lane & 15, fq = c.lane >> 4, q = 16 * rt + fr;
            const LAS float* sb = scl + (ck & 1) * 400;
            const size_t row0 = (size_t)bb * SEQ + ck * CH;
#pragma unroll
            for (int i = 0; i < 4; ++i) { const int pc = c.tid + 512 * i, rw = pc >> 4, cc = pc & 15; *(LAS u32x4*)(RC + rw * TP + cc * 16) = ncp[i]; *(LAS u32x4*)(RB + rw * TP + cc * 16) = nbp[i]; }
            if (w < 4) {
#pragma unroll
                for (int i = 0; i < 4; ++i) { const int px = c.tid + 256 * i, rw = px >> 3, cc = px & 7; const u32x4 r = nxp[i]; const float sc = sb[256 + rw];
                    *(LAS u32x4*)(RX + rw * XP + cc * 16) = r;
                    u32x4 s4; s4.x = pkbf(bf_lo(r.x) * sc, bf_hi(r.x) * sc); s4.y = pkbf(bf_lo(r.y) * sc, bf_hi(r.y) * sc); s4.z = pkbf(bf_lo(r.z) * sc, bf_hi(r.z) * sc); s4.w = pkbf(bf_lo(r.w) * sc, bf_hi(r.w) * sc);
                    *(LAS u32x4*)(RX2 + rw * XP + cc * 16) = s4; } }
#pragma unroll
            for (int t = 0; t < 4; ++t) { u32x2 o; o.x = pkbf(hs[t][0], hs[t][1]); o.y = pkbf(hs[t][2], hs[t][3]); *(LAS u32x2*)(RH + (16 * pt + fr) * TP + (16 * (nt0 + t) + 4 * fq) * 2) = o; }
            __syncthreads();
            u32x2 zz[4];
#pragma unroll
            for (int p4 = 0; p4 < 4; ++p4) zz[p4] = nzz[p4];
            if (ck + 1 < NCHUNK) STAGE_LOADS(ck + 1);
            bf16x8 cfr[4];
#pragma unroll
            for (int ks = 0; ks < 4; ++ks) cfr[ks] = *(const LAS bf16x8*)(RC + q * TP + (32 * ks + 8 * fq) * 2);
            f32x4 ao[4];
#pragma unroll
            for (int p4 = 0; p4 < 4; ++p4) { ao[p4] = (f32x4){0.f, 0.f, 0.f, 0.f};
#pragma unroll
                for (int ks = 0; ks < 4; ++ks) { const bf16x8 hf = *(const LAS bf16x8*)(RH + (16 * p4 + fr) * TP + (32 * ks + 8 * fq) * 2); ao[p4] = __builtin_amdgcn_mfma_f32_16x16x32_bf16(hf, cfr[ks], ao[p4], 0, 0, 0); } }
            const float aq = sb[q];
            const int npm1 = rt >> 1;
            {
                bf16x8 b0[4], b1[4]; f32x4 as0, ds0, as1, ds1;
#define SCAN_LOADP(u_) do { _Pragma("unroll") for (int ks = 0; ks < 4; ++ks) { b0[ks] = *(const LAS bf16x8*)(RB + (32 * (u_) + fr) * TP + (32 * ks + 8 * fq) * 2); b1[ks] = *(const LAS bf16x8*)(RB + (32 * (u_) + 16 + fr) * TP + (32 * ks + 8 * fq) * 2); } \
                    as0 = *(const LAS f32x4*)(sb + 32 * (u_) + 4 * fq); as1 = *(const LAS f32x4*)(sb + 32 * (u_) + 16 + 4 * fq); ds0 = *(const LAS f32x4*)(sb + 128 + 32 * (u_) + 4 * fq); ds1 = *(const LAS f32x4*)(sb + 128 + 32 * (u_) + 16 + 4 * fq); } while (0)
                SCAN_LOADP(0);
#pragma unroll 1
                for (int u = 0; ; ++u) {
                    f32x4 c0 = (f32x4){0.f, 0.f, 0.f, 0.f}, c1 = c0;
#pragma unroll
                    for (int ks = 0; ks < 4; ++ks) { c0 = __builtin_amdgcn_mfma_f32_16x16x32_bf16(b0[ks], cfr[ks], c0, 0, 0, 0); c1 = __builtin_amdgcn_mfma_f32_16x16x32_bf16(b1[ks], cfr[ks], c1, 0, 0, 0); }
                    const f32x4 a0 = as0, d0 = ds0, a1 = as1, d1 = ds1;
                    const bool lastp = (u == npm1);
                    if (!lastp) SCAN_LOADP(u + 1);
                    float l0[4], l1[4];
#pragma unroll
                    for (int e = 0; e < 4; ++e) { const int s = 32 * u + 4 * fq + e;
                        const float v0 = c0[e] * exp_f(fminf(aq - a0[e], 0.f)) * d0[e], v1 = c1[e] * exp_f(fminf(aq - a1[e], 0.f)) * d1[e];
                        l0[e] = (s <= q) ? v0 : 0.f; l1[e] = (s + 16 <= q) ? v1 : 0.f; }
                    u32x2 o0, o1; o0.x = pkbf(l0[0], l0[1]); o0.y = pkbf(l0[2], l0[3]); o1.x = pkbf(l1[0], l1[1]); o1.y = pkbf(l1[2], l1[3]);
                    *(LAS u32x2*)(RC + q * TP + (32 * u + 4 * fq) * 2) = o0; *(LAS u32x2*)(RC + q * TP + (32 * u + 16 + 4 * fq) * 2) = o1;
                    if (lastp) break;
                }
#undef SCAN_LOADP
            }
            f32x4 ay[4];
#pragma unroll
            for (int p4 = 0; p4 < 4; ++p4) ay[p4] = (f32x4){0.f, 0.f, 0.f, 0.f};
            {
                bf16x8 lfc, xc[4], lfn, xn[4];
#define SCAN_LOADY(ks_, lf_, x_) do { lf_ = *(const LAS bf16x8*)(RC + q * TP + (32 * (ks_) + 8 * fq) * 2); _Pragma("unroll") for (int p4 = 0; p4 < 4; ++p4) x_[p4] = lds_tr_frag(RX, XP, 32 * (ks_), 16 * p4, c.lane); } while (0)
                SCAN_LOADY(0, lfc, xc);
#pragma unroll 1
                for (int ks = 0; ; ++ks) {
                    const bool lastk = (ks == npm1);
                    const int kn = lastk ? ks : ks + 1;
                    SCAN_LOADY(kn, lfn, xn);
#pragma unroll
                    for (int p4 = 0; p4 < 4; ++p4) ay[p4] = __builtin_amdgcn_mfma_f32_16x16x32_bf16(xc[p4], lfc, ay[p4], 0, 0, 0);
                    if (lastk) break;
                    lfc = lfn;
#pragma unroll
                    for (int p4 = 0; p4 < 4; ++p4) xc[p4] = xn[p4];
                }
#undef SCAN_LOADY
            }
            const float eq = exp_f(aq); float ssq = 0.f;
#pragma unroll
            for (int p4 = 0; p4 < 4; ++p4) {
                const int pc = 16 * p4 + 4 * fq; const float zf[4] = {bf_lo(zz[p4].x), bf_hi(zz[p4].x), bf_lo(zz[p4].y), bf_hi(zz[p4].y)}; float yv[4];
                const u32x2 xr = *(const LAS u32x2*)(RX + q * XP + pc * 2); const float xf4[4] = {bf_lo(xr.x), bf_hi(xr.x), bf_lo(xr.y), bf_hi(xr.y)};
#pragma unroll
                for (int e = 0; e < 4; ++e) { const float y = (ay[p4][e] + eq * ao[p4][e] + Dh * xf4[e]) * zf[e]; yv[e] = y; ssq += y * y; }
                u32x2 o; o.x = pkbf(yv[0], yv[1]); o.y = pkbf(yv[2], yv[3]); *(u32x2*)(YN + ((size_t)(((row0 + q) >> 8) * 32 + h) * 256 + ((row0 + q) & 255)) * 64 + pc) = o;
            }
            ssq += __shfl_xor(ssq, 16); ssq += __shfl_xor(ssq, 32);
            if (fq == 0) SSY[(row0 + q) * 32 + h] = ssq;
            {
                f32x4 S[4];
#pragma unroll
                for (int t = 0; t < 4; ++t) S[t] = (f32x4){0.f, 0.f, 0.f, 0.f};
#pragma unroll
                for (int ks = 0; ks < 4; ++ks) { const bf16x8 a = lds_tr_frag(RX2, XP, 32 * ks, 16 * pt, c.lane);
#pragma unroll
                    for (int t = 0; t < 4; ++t) { const bf16x8 b2 = lds_tr_frag(RB, TP, 32 * ks, 16 * (nt0 + t), c.lane); S[t] = __builtin_amdgcn_mfma_f32_16x16x32_bf16(b2, a, S[t], 0, 0, 0); } }
                const float cdec = sb[384];
#pragma unroll
                for (int t = 0; t < 4; ++t) hs[t] = hs[t] * cdec + S[t];
            }
            if (w == 1 && ck + 1 < NCHUNK) SSD_SCALE(ck + 1);
            __syncthreads();
        }
#undef SSD_SCALE
#undef STAGE_LOADS
        { int lz = c.lane; asm volatile("" : "+v"(lz));
          float* so = c.out + O_SSMP + ((((size_t)j * NB + bb) * NH + h) * HD + 16 * pt + (lz & 15)) * NST + 16 * nt0 + 4 * (lz >> 4);
#pragma unroll
          for (int t = 0; t < 4; ++t) *(f32x4*)(so + 16 * t) = hs[t]; }
    }
}

__device__ __forceinline__ void phase_cm_mix(const Ctx& c0, int j, bf16_t* Uout, bool do_sample) {
    PHASE_CTX(c0);
    const bf16_t* U = (const bf16_t*)(c.ws + WS_ZS); const bf16_t* GV = (const bf16_t*)(c.ws + WS_XBC); const float* SSV = (const float*)(c.ws + WS_SSV);
    const float* vg = c.in[17] + (size_t)j * CW; const float* bs = c.in[19] + (size_t)j * NG * CH; const float* wsm = c.in[18] + (size_t)j * NG * CH * CH;
    LAS unsigned char* GT = c.lds;
    LAS float* rsv = (LAS float*)(c.lds + 104448);
    const int w = c.wave, rt = (w < 4) ? w : 11 - w, fr = c.lane & 15, fq = c.lane >> 4, q = 16 * rt + fr;
    if (do_sample && c.blk < MS) { const int row = c.blk; const float* GVS = (const float*)(c.ws + WS_GVS); bf16_t* US = (bf16_t*)(c.ws + WS_US);
        const float rs = row_rstd((const float*)(c.ws + WS_SSVS), 32, row, 1.f / 2048.f);
        const int d0 = 4 * c.tid, g = d0 >> 8; const f32x4 gv = *(const f32x4*)(GVS + (size_t)row * CW + d0), vgv = *(const f32x4*)(vg + d0);
        const f32x4 v = gv * rs * vgv; *(f32x4*)(c.out + O_CMV + ((size_t)j * MS + row) * CW + d0) = v;
        const float w00 = wsm[(size_t)g * CH * CH], b0 = bs[g * CH];
        const u32x2 uu = *(const u32x2*)(US + frag_off(row, phys256(d0), CW)); const f32x4 sv = v * w00 + b0;
        u32x2 o; o.x = pkbf(bf_lo(uu.x) * sv.x, bf_hi(uu.x) * sv.y); o.y = pkbf(bf_lo(uu.y) * sv.z, bf_hi(uu.y) * sv.w); *(u32x2*)(US + frag_off(row, phys256(d0), CW)) = o; }
    { const int k = c.tid >> 7, item = c.blk + k * c.G; if (item < NB * NCHUNK * NG) { const int rowk = (item >> 7) * SEQ + ((item >> 3) & 15) * CH + (c.tid & 127); rsv[c.tid] = row_rstd(SSV, 8, rowk, 1.f / 2048.f); } }
    __syncthreads();
    constexpr int NIT = NB * NCHUNK * NG;
    const int nh = c.blk < NIT ? 2 * ((NIT - 1 - c.blk) / c.G + 1) : 0;
    LAS unsigned char* usw = c.lds + 108544 + w * 4352;
    u32x4 raw[4], ur[4];
    float wfl[4][8]; bf16x8 wf[4]; float bq = 0.f; int gcur = -1;
#pragma unroll
    for (int ks = 0; ks < 4; ++ks) { wf[ks] = (bf16x8){0, 0, 0, 0, 0, 0, 0, 0};
#pragma unroll
        for (int e = 0; e < 8; ++e) wfl[ks][e] = 0.f; }
#define MIX_LOADS(hh) do { const int it_ = c.blk + ((hh) >> 1) * c.G, g_ = it_ & 7, hp_ = (hh) & 1; const size_t r0_ = (size_t)(it_ >> 7) * SEQ + ((it_ >> 3) & 15) * CH; \
        _Pragma("unroll") for (int i = 0; i < 4; ++i) { const int pid = c.tid + 512 * i; raw[i] = *(const u32x4*)(GV + ((size_t)(((it_ >> 3) * 8 + g_) * 2 + hp_) * 128) * 128 + pid * 8); } \
        _Pragma("unroll") for (int i = 0; i < 4; ++i) { const size_t rw_ = r0_ + 16 * rt + 4 * i + fq; ur[i] = *(const u32x4*)(U + ((size_t)((rw_ >> 8) * 32 + g_ * 4 + 2 * hp_ + (fr >> 3)) * 256 + (rw_ & 255)) * 64 + (fr & 7) * 8); } } while (0)
    if (nh > 0) MIX_LOADS(0);
#pragma unroll 1
    for (int h_ = 0; h_ < nh; ++h_) {
        int h = h_; asm volatile("" : "+s"(h));
        const int item = c.blk + (h >> 1) * c.G, hp = h & 1, g = item & 7;
        const size_t row0 = (size_t)(item >> 7) * SEQ + ((item >> 3) & 15) * CH;
        LAS unsigned char* gt = GT + (h & 1) * (128 * TP);
        if (hp == 0) {
            if (g != gcur) { gcur = g;
#pragma unroll
                for (int ks = 0; ks < 4; ++ks) { const int s0 = 32 * ks + 8 * fq; const float* wp = wsm + ((size_t)g * CH + q) * CH + s0; const f32x4 a = *(const f32x4*)wp, bb4 = *(const f32x4*)(wp + 4);
#pragma unroll
                    for (int e = 0; e < 4; ++e) { wfl[ks][e] = (s0 + e <= q) ? a[e] : 0.f; wfl[ks][4 + e] = (s0 + 4 + e <= q) ? bb4[e] : 0.f; } } }
            bq = bs[g * CH + q];
            const LAS float* rsk = rsv + ((h >> 1) & 3) * 128;
#pragma unroll
            for (int ks = 0; ks < 4; ++ks) { const f32x4 r0 = *(const LAS f32x4*)(rsk + 32 * ks + 8 * fq), r1 = *(const LAS f32x4*)(rsk + 32 * ks + 8 * fq + 4);
                u32x4 o; o.x = pkbf(wfl[ks][0] * r0[0], wfl[ks][1] * r0[1]); o.y = pkbf(wfl[ks][2] * r0[2], wfl[ks][3] * r0[3]); o.z = pkbf(wfl[ks][4] * r1[0], wfl[ks][5] * r1[1]); o.w = pkbf(wfl[ks][6] * r1[2], wfl[ks][7] * r1[3]);
                wf[ks] = __builtin_bit_cast(bf16x8, o); }
        }
#pragma unroll
        for (int i = 0; i < 4; ++i) { const int pid = c.tid + 512 * i; *(LAS u32x4*)(gt + (pid >> 4) * TP + (pid & 15) * 16) = raw[i]; }
#pragma unroll
        for (int i = 0; i < 4; ++i) *(LAS u32x4*)(usw + (4 * i + fq) * TP + fr * 16) = ur[i];
        asm volatile("s_waitcnt lgkmcnt(0)" ::: "memory"); __builtin_amdgcn_s_barrier(); asm volatile("" ::: "memory");
        if (h + 1 < nh) MIX_LOADS(h + 1);
        f32x4 vgvr[8];
#pragma unroll
        for (int k = 0; k < 8; ++k) { const int t = 8 * (k >> 2) + 4 * hp + (k & 3); vgvr[k] = *(const f32x4*)(vg + g * 256 + 16 * t + 4 * fq); }
        f32x4 acc[8];
#pragma unroll
        for (int k = 0; k < 8; ++k) acc[k] = (f32x4){0.f, 0.f, 0.f, 0.f};
#pragma unroll
        for (int ks = 0; ks < 4; ++ks) {
            if (ks <= (rt >> 1)) {
#pragma unroll
                for (int k = 0; k < 8; ++k) { const bf16x8 gf = lds_tr_frag(gt, TP, 32 * ks, 64 * ((k >> 1) & 1) + 32 * (k >> 2) + 16 * (k & 1), c.lane); acc[k] = __builtin_amdgcn_mfma_f32_16x16x32_bf16(gf, wf[ks], acc[k], 0, 0, 0); } } }
#pragma unroll
        for (int k = 0; k < 8; ++k) { const int so = (64 * ((k >> 1) & 1) + 32 * (k >> 2) + 16 * (k & 1) + 4 * fq) * 2;
            const u32x2 u2 = *(const LAS u32x2*)(usw + fr * TP + so); const f32x4 sv = acc[k] * vgvr[k] + bq;
            u32x2 o; o.x = pkbf(bf_lo(u2.x) * sv.x, bf_hi(u2.x) * sv.y); o.y = pkbf(bf_lo(u2.y) * sv.z, bf_hi(u2.y) * sv.w); *(LAS u32x2*)(usw + fr * TP + so) = o; }
#pragma unroll
        for (int i = 0; i < 4; ++i) { const u32x4 o4 = *(const LAS u32x4*)(usw + (4 * i + fq) * TP + fr * 16);
            const size_t rw = row0 + 16 * rt + 4 * i + fq; *(u32x4*)(Uout + ((size_t)((rw >> 8) * 32 + g * 4 + 2 * hp + (fr >> 3)) * 256 + (rw & 255)) * 64 + (fr & 7) * 8) = o4; }
    }
#undef MIX_LOADS
    __syncthreads();
}

__device__ __forceinline__ void sample_resid(const Ctx& c0, const bf16_t* A, int K, const bf16_t* Wt, const float* base, size_t dummy_off = 0) {
    PHASE_CTX(c0);
    float* XS = (float*)(c.ws + WS_XS + dummy_off); bf16_t* XSB = (bf16_t*)(c.ws + WS_XSB + dummy_off); float* SSS = (float*)(c.ws + WS_SSS + dummy_off);
    const int fr = c.lane & 15, fq = c.lane >> 4;
    for (int task = c.blk; task < 256; task += c.G) { const int tile = task & 63, rq = task >> 6;
        f32x4 bv = (f32x4){0.f, 0.f, 0.f, 0.f}; if (c.wave < 2) bv = *(const f32x4*)(base + (size_t)(32 * rq + 16 * c.wave + fr) * D + 16 * tile + 4 * fq);
        const f32x4 a = block_gemm_ks<2, 8, true>(c.wave, c.lane, A, K, 32 * rq, Wt, K, 16 * tile, (LAS float*)c.lds);
        if (c.wave < 2) { const int row = 32 * rq + 16 * c.wave + fr, col = 16 * tile + 4 * fq; const f32x4 v = a + bv;
            *(f32x4*)(XS + (size_t)row * D + col) = v; u32x2 o; o.x = pkbf(v.x, v.y); o.y = pkbf(v.z, v.w); *(u32x2*)(XSB + frag_off(row, col, D)) = o;
            float ss = dot4(v); ss += __shfl_xor(ss, 16); ss += __shfl_xor(ss, 32); if (fq == 0) SSS[row * 64 + tile] = ss; } }
    __syncthreads();
}
__device__ __forceinline__ void sample_ssd_in(const Ctx& c0, int j) {
    PHASE_CTX(c0);
    const bf16_t* XSB = (const bf16_t*)(c.ws + WS_XSB); const float* SSS = (const float*)(c.ws + WS_SSS); const bf16_t* Wt = (const bf16_t*)(c.ws + WS_WSI + j * WSI_STRIDE);
    float* ZSS = (float*)(c.ws + WS_ZSS); float* XBCS = (float*)(c.ws + WS_XBCS); float* DTS = (float*)(c.ws + WS_DTS);
    const int fr = c.lane & 15, fq = c.lane >> 4; const int row = 16 * c.wave + fr; const float rs = row_rstd(SSS, 16, row, 1.f / 1024.f);
    for (int pair = c.blk; pair < INDIM / 32; pair += c.G) {
        f32x4 vv[2]; block_gemm_ks2(c.wave, c.lane, XSB, Wt, D, 32 * pair, (LAS float*)c.lds, vv[0], vv[1]);
#pragma unroll
        for (int e2 = 0; e2 < 2; ++e2) { f32x4 v = vv[e2] * rs; const int col = 32 * pair + 16 * e2 + 4 * fq;
            if (col < DI) { v.x = silu_f(v.x); v.y = silu_f(v.y); v.z = silu_f(v.z); v.w = silu_f(v.w); *(f32x4*)(ZSS + (size_t)row * DI + col) = v; }
            else if (col < INMAIN) *(f32x4*)(XBCS + (size_t)row * CONVD + col - DI) = v;
            else { const int h = col - INMAIN; const f32x4 b = *(const f32x4*)(c.in[10] + j * NH + h); v.x = softplus_f(v.x + b.x); v.y = softplus_f(v.y + b.y); v.z = softplus_f(v.z + b.z); v.w = softplus_f(v.w + b.w); *(f32x4*)(DTS + row * 32 + h) = v; } } }
    __syncthreads();
}
__device__ __forceinline__ void prompt_dt(const Ctx& c0, int j) {
    PHASE_CTX(c0);
    const bf16_t* XB = (const bf16_t*)(c.ws + WS_XB); const float* SS = (const float*)(c.ws + WS_SS); const bf16_t* Wt = (const bf16_t*)(c.ws + WS_WSI + j * WSI_STRIDE) + (size_t)INMAIN * D;
    float* DT = (float*)(c.ws + WS_DT); const int fr = c.lane & 15, fq = c.lane >> 4;
    for (int task = c.blk; task < 256; task += c.G) { const int r0 = (task >> 1) * 128, ct = task & 1;
        const int row = r0 + 16 * c.wave + fr, h = 16 * ct + 4 * fq; const float rs = row_rstd(SS, 4, row, 1.f / 1024.f); const f32x4 b = *(const f32x4*)(c.in[10] + j * NH + h);
        const f32x4 a = block_gemm_ks<8, 4, false>(c.wave, c.lane, XB, D, r0, Wt, D, 16 * ct, (LAS float*)c.lds);
        f32x4 v = a * rs + b;
        v.x = softplus_f(v.x); v.y = softplus_f(v.y); v.z = softplus_f(v.z); v.w = softplus_f(v.w); *(f32x4*)(DT + (size_t)row * 32 + h) = v; }
    __syncthreads();
}
__device__ __forceinline__ void sample_mlp_up(const Ctx& c0, int i) {
    PHASE_CTX(c0);
    const bf16_t* XSB = (const bf16_t*)(c.ws + WS_XSB); const float* SSS = (const float*)(c.ws + WS_SSS); const bf16_t* Wt = (const bf16_t*)(c.ws + WS_WUP + i * WUP_STRIDE); bf16_t* HS = (bf16_t*)(c.ws + WS_HS);
    const int fr = c.lane & 15, fq = c.lane >> 4; const int row = 16 * c.wave + fr; const float rs = row_rstd(SSS, 16, row, 1.f / 1024.f);
    for (int tile = c.blk; tile < FF / 16; tile += c.G) {
        f32x4 v = block_gemm_ks<8, 4, true>(c.wave, c.lane, XSB, D, 0, Wt, D, 16 * tile, (LAS float*)c.lds) * rs;
        v.x = fmaxf(v.x, 0.f); v.y = fmaxf(v.y, 0.f); v.z = fmaxf(v.z, 0.f); v.w = fmaxf(v.w, 0.f);
        u32x2 o; o.x = pkbf(v.x * v.x, v.y * v.y); o.y = pkbf(v.z * v.z, v.w * v.w); *(u32x2*)(HS + frag_off(row, phys256(16 * tile + 4 * fq), FF)) = o; }
    __syncthreads();
}
__device__ __forceinline__ void sample_cm_in(const Ctx& c0, int j) {
    PHASE_CTX(c0);
    const bf16_t* XSB = (const bf16_t*)(c.ws + WS_XSB); const float* SSS = (const float*)(c.ws + WS_SSS); const bf16_t* Wt = (const bf16_t*)(c.ws + WS_WCI + j * WCI_STRIDE);
    bf16_t* US = (bf16_t*)(c.ws + WS_US); float* GVS = (float*)(c.ws + WS_GVS); float* SSVS = (float*)(c.ws + WS_SSVS); const float* bias = c.in[16] + (size_t)j * 4096;
    const int fr = c.lane & 15, fq = c.lane >> 4; const int row = 16 * c.wave + fr; const float rs = row_rstd(SSS, 16, row, 1.f / 1024.f);
    for (int tile = c.blk; tile < 4096 / 16; tile += c.G) {
        const int col = 16 * tile + 4 * fq; const f32x4 bv = *(const f32x4*)(bias + col);
        const f32x4 a0 = block_gemm_ks<8, 4, true>(c.wave, c.lane, XSB, D, 0, Wt, D, 16 * tile, (LAS float*)c.lds);
        const f32x4 v = a0 * rs + bv;
        const f32x2 a = pg8::gelu_pk((f32x2){v.x, v.y}), b = pg8::gelu_pk((f32x2){v.z, v.w});
        if (col < CW) { u32x2 o; o.x = pkbf(a.x, a.y); o.y = pkbf(b.x, b.y); *(u32x2*)(US + frag_off(row, phys256(col), CW)) = o; }
        else { *(f32x4*)(GVS + (size_t)row * CW + col - CW) = (f32x4){a.x, a.y, b.x, b.y}; float ss = (a.x * a.x + a.y * a.y) + (b.x * b.x + b.y * b.y);
            ss += __shfl_xor(ss, 16); ss += __shfl_xor(ss, 32); if (fq == 0) SSVS[row * 128 + (tile - 128)] = ss; } }
    __syncthreads();
}

__device__ __forceinline__ void phase_final(const Ctx& c0) {
    PHASE_CTX(c0);
    const int gw = c.blk * NWAVES + c.wave, NGW = c.G * NWAVES; const float* gf = c.in[6];
    for (int m = gw; m < M + MS; m += NGW) {
        if (m < M) { const bf16_t* x = (const bf16_t*)(c.ws + WS_XB) + (size_t)m * D; float* y = c.out + O_Y + (size_t)m * D; const float rs = row_rstd((const float*)(c.ws + WS_SS), 4, m, 1.f / 1024.f);
#pragma unroll
            for (int jx = 0; jx < 4; ++jx) { const int col = 4 * c.lane + 256 * jx; const u32x2 p = *(const u32x2*)(x + col); *(f32x4*)(y + col) = (f32x4){bf_lo(p.x), bf_hi(p.x), bf_lo(p.y), bf_hi(p.y)} * rs * *(const f32x4*)(gf + col); } }
        else { const int r = m - M; const float* x = (const float*)(c.ws + WS_XS) + (size_t)r * D; float* y = c.out + O_YS + (size_t)r * D; const float rs = row_rstd((const float*)(c.ws + WS_SSS), 16, r, 1.f / 1024.f);
#pragma unroll
            for (int jx = 0; jx < 4; ++jx) { const int col = 4 * c.lane + 256 * jx; *(f32x4*)(y + col) = *(const f32x4*)(x + col) * rs * *(const f32x4*)(gf + col); } }
    }
}
#define XB_TMO      128
#define XB_XCNT(j)  (256  + 64 * (j))
#define XB_XSUB(j)  (1280 + 64 * (j))
#define XB_XGEN(j)  (2304 + 64 * (j))
#define XB_TOP      3328
#define XB_TOPGEN   3392
#define XCD_BAR_WORDS 3456
#define XB_SPIN_CAP (1u << 18)

__device__ __forceinline__ unsigned xb_ld(unsigned* p)              { return __hip_atomic_load(p, __ATOMIC_RELAXED, __HIP_MEMORY_SCOPE_AGENT); }
__device__ __forceinline__ unsigned xb_add(unsigned* p, unsigned v) { return __hip_atomic_fetch_add(p, v, __ATOMIC_RELAXED, __HIP_MEMORY_SCOPE_AGENT); }
__device__ __forceinline__ unsigned xb_xcc_id() { return (unsigned)__builtin_amdgcn_s_getreg((3 << 11) | 20) & 0xFu; }
#define XB_SPIN(cond, bar) do { unsigned _sp = 0; while (cond) { __builtin_amdgcn_s_sleep(1); \
    if ((++_sp & 255u) == 0u) { if (xb_ld(&(bar)[XB_TMO])) break; if (_sp > XB_SPIN_CAP) { atomicAdd(&(bar)[XB_TMO], 1u); break; } } } } while (0)

struct XcdBarrier {
    unsigned* bar; unsigned x;
    volatile LAS unsigned* st;
};

__device__ __forceinline__ XcdBarrier xcd_barrier_post(unsigned* bar, volatile LAS unsigned* st) {
    XcdBarrier b; b.bar = bar; b.x = xb_xcc_id(); b.st = st;
    if (threadIdx.x == 0) (void)xb_add(&bar[XB_XCNT(b.x)], 1u);
    return b;
}
__device__ __forceinline__ void xcd_barrier_complete(unsigned* bar, unsigned x, unsigned& nloc, unsigned& nx) {
    const unsigned G = gridDim.x * gridDim.y * gridDim.z;
    unsigned sum, cnt, mine, sp = 0u;
    for (;;) {
        sum = 0u; cnt = 0u; mine = 0u;
#pragma unroll
        for (unsigned j = 0; j < 16; ++j) { const unsigned c = xb_ld(&bar[XB_XCNT(j)]); sum += c; cnt += (c > 0u) ? 1u : 0u; mine = (j == x) ? c : mine; }
        if (sum == G) break;
        __builtin_amdgcn_s_sleep(1);
        if ((++sp & 255u) == 0u) { if (xb_ld(&bar[XB_TMO])) break; if (sp > XB_SPIN_CAP) { atomicAdd(&bar[XB_TMO], 1u); break; } }
    }
    nloc = mine > 0u ? mine : 1u; nx = cnt > 0u ? cnt : 1u;
}

__device__ __forceinline__ void xcd_barrier(const XcdBarrier& b) {
    asm volatile("s_waitcnt vmcnt(0)" ::: "memory");
    __syncthreads();
    if (threadIdx.x == 0) {
        unsigned* bar = b.bar;
        __builtin_amdgcn_s_waitcnt(0);
        unsigned nloc = b.st[0], nx = b.st[1];
        if (nloc == 0u) { xcd_barrier_complete(bar, b.x, nloc, nx); b.st[0] = nloc; b.st[1] = nx; }
        const unsigned old = xb_add(&bar[XB_XSUB(b.x)], 1u);
        const unsigned gen = old / nloc;
        if (old + 1u == (gen + 1u) * nloc) {
            __builtin_amdgcn_fence(__ATOMIC_RELEASE, "agent");
            asm volatile("s_waitcnt vmcnt(0)" ::: "memory");
            const unsigned og = xb_add(&bar[XB_TOP], 1u);
            asm volatile("buffer_inv sc1" ::: "memory");
            const unsigned tg = og / nx;
            if (og + 1u == (tg + 1u) * nx) xb_add(&bar[XB_TOPGEN], 1u);
            else XB_SPIN(xb_ld(&bar[XB_TOPGEN]) == tg, bar);
            xb_add(&bar[XB_XGEN(b.x)], 1u);
            asm volatile("s_waitcnt vmcnt(0)" ::: "memory");
        } else {
            asm volatile("buffer_inv sc1" ::: "memory");
            XB_SPIN(xb_ld(&bar[XB_XGEN(b.x)]) == gen, bar);
            asm volatile("s_waitcnt vmcnt(0)" ::: "memory");
        }
    }
    __syncthreads();
}

#ifndef PH_MASK
#define PH_MASK 0xffffffffu
#endif
#define PHM(k) ((PH_MASK >> (k)) & 1u)
#ifndef STAGGER
#define STAGGER 1
#endif
#ifndef REP_PRO
#define REP_PRO 1
#endif
#ifndef REP_SSDIN
#define REP_SSDIN 1
#endif
#ifndef REP_SCAN1
#define REP_SCAN1 1
#endif
#ifndef REP_SSAMP
#define REP_SSAMP 1
#endif
#ifndef REP_SCAN2
#define REP_SCAN2 1
#endif
#ifndef REP_UP
#define REP_UP 1
#endif
#ifndef REP_CMIN
#define REP_CMIN 1
#endif
#ifndef REP_RESID
#define REP_RESID 1
#endif
#ifndef REP_SRES
#define REP_SRES 1
#endif
#ifndef REP_MIX
#define REP_MIX 1
#endif
#ifndef REP_FIN
#define REP_FIN 1
#endif
#define REPEAT(n) _Pragma("unroll 1") for (int rep_ = 0; rep_ < (n); ++rep_)
struct Args { const float* in[23]; float* out; unsigned char* ws; int ph_lo, ph_hi; };

__global__ void __launch_bounds__(NTHR, 2) hyb_fwd(Args args) {
    extern __shared__ __attribute__((aligned(16))) unsigned char lds_raw[];
    Ctx c;
#pragma unroll
    for (int i = 0; i < 23; ++i) c.in[i] = args.in[i];
    c.out = args.out; c.ws = args.ws;
    c.lds = (LAS unsigned char*)lds_raw;
    c.tid = threadIdx.x; c.lane = c.tid & 63; c.wave = __builtin_amdgcn_readfirstlane(c.tid >> 6); c.blk = blockIdx.x; c.G = gridDim.x;
    volatile LAS unsigned* lctl = (volatile LAS unsigned*)(c.lds + LDSCTL_OFF);
    if (c.tid < 128) lctl[c.tid] = 0u;
    __syncthreads();
    const int lo = args.ph_lo, hi = args.ph_hi;
    XcdBarrier bar; bar.bar = (unsigned*)(c.ws + WS_CTL) + CW_BAR; bar.x = 0; bar.st = lctl;
    if (hi - lo > 1) bar = xcd_barrier_post((unsigned*)(c.ws + WS_CTL) + CW_BAR, lctl);

#pragma unroll 1
    for (int ph_ = lo; ph_ < hi; ++ph_) {
        int ph = ph_; asm volatile("" : "+s"(ph));
        int L = 0, idx = 0, kind;
        if (ph == 0) kind = 0;
        else if (ph == NPHASE - 1) kind = 8;
        else { const int q = ph - 1;
            if (q < 6) { L = 0; idx = q; } else if (q < 11) { L = 1; idx = q - 6; } else if (q < 17) { L = 2; idx = q - 11; } else { L = 3; idx = q - 17; }
            if ((L & 1) == 0) kind = idx == 0 ? 1 : idx == 1 ? 2 : idx == 2 ? 3 : idx == 3 ? 4 : idx == 4 ? 7 : 4;
            else kind = idx == 0 ? 5 : idx == 1 ? 6 : idx == 2 ? 4 : idx == 3 ? 7 : 4; }
        const int j = L >> 1;
        bf16_t* const XB = (bf16_t*)(c.ws + WS_XB); float* const SS = (float*)(c.ws + WS_SS);
        if (kind == 0) { REPEAT(REP_PRO) { phase_prologue(c); if (rep_ + 1 < REP_PRO) __syncthreads(); } }
        else if (kind == 1) {
            REPEAT(REP_SSDIN) {
            const bool late = STAGGER && ((c.blk >> 3) & 1);
            if (!late) { sample_ssd_in(c, j); prompt_dt(c, j); }
            pg8::Gemm g{XB, (const bf16_t*)(c.ws + WS_WSI + j * WSI_STRIDE), M, INMAIN, D}; pg8::StaticOrder S; S.init(M, INMAIN, c.G, c.blk);
            pg8::EpiSsdIn E{(const LAS float*)(c.lds + RSTAB_OFF), (bf16_t*)(c.ws + WS_ZS), (bf16_t*)(c.ws + WS_XBC), c.out + O_CONVP + (size_t)j * NB * 3 * CONVD, c.lds + EPISCR_OFF, c.lds, SS, c.blk};
            pg8::gemm_phase<pg8::EpiSsdIn, pg8::StaticOrder, true, true>(c.lds, g, S, E, c.wave);
            if (late) { sample_ssd_in(c, j); prompt_dt(c, j); } }
        }
        else if (kind == 2) { REPEAT(REP_SCAN1) phase_conv(c, j); }
        else if (kind == 3) { REPEAT(REP_SCAN2) phase_ssd_scan(c, j); }
        else if (kind == 4) {
            const bool ssd = (L & 1) == 0; const bool down = ssd ? idx == 5 : idx == 4;
            const bf16_t* A = (const bf16_t*)(c.ws + (down ? WS_HB : ssd ? WS_YN : WS_ZS));
            const bf16_t* As = (const bf16_t*)(c.ws + (down ? WS_HS : ssd ? WS_YNS : WS_US));
            const bf16_t* Wt = (const bf16_t*)(c.ws + (down ? WS_WDN + L * WDN_STRIDE : ssd ? WS_WSO + j * WSO_STRIDE : WS_WCO + j * WCO_STRIDE));
            const int K = down ? FF : DI;
            const bool first = (L == 0) && !down;
            const float* xsbase = first ? c.in[1] : (const float*)(c.ws + WS_XS);
            REPEAT(REP_SRES - 1) sample_resid(c, As, K, Wt, xsbase, 800 * MiB);
            sample_resid(c, As, K, Wt, xsbase);
            pg8::Gemm g{A, Wt, M, D, K}; pg8::StaticOrder S; S.init(M, D, c.G, c.blk);
            if (ssd && !down) {
                pg8::EpiResidG E{XB, SS, (const LAS float*)(c.lds + RGTAB_OFF), c.lds, (const float*)(c.ws + WS_SSY), c.blk};
                pg8::gemm_phase<pg8::EpiResidG, pg8::StaticOrder, true, true, true>(c.lds, g, S, E, c.wave);
            } else {
                pg8::EpiResid E{XB, SS};
                pg8::gemm_phase<pg8::EpiResid, pg8::StaticOrder, true, true, true>(c.lds, g, S, E, c.wave);
            }
        }
        else if (kind == 5) {
            REPEAT(REP_CMIN) {
            const bool late = STAGGER && ((c.blk >> 3) & 1);
            if (!late) sample_cm_in(c, j);
            pg8::Gemm g{XB, (const bf16_t*)(c.ws + WS_WCI + j * WCI_STRIDE), M, 4096, D}; pg8::StaticOrder S; S.init(M, 4096, c.G, c.blk);
            pg8::EpiCmIn E{(const LAS float*)(c.lds + RSTAB_OFF), c.in[16] + (size_t)j * 4096, (bf16_t*)(c.ws + WS_ZS), (bf16_t*)(c.ws + WS_XBC), (float*)(c.ws + WS_SSV), c.lds + EPISCR_OFF, c.lds, SS, c.blk};
            pg8::gemm_phase<pg8::EpiCmIn, pg8::StaticOrder, true, true>(c.lds, g, S, E, c.wave);
            if (late) sample_cm_in(c, j); }
        }
        else if (kind == 6) { REPEAT(REP_MIX - 1) phase_cm_mix(c, j, (bf16_t*)(c.ws + 700 * MiB), false); phase_cm_mix(c, j, (bf16_t*)(c.ws + WS_ZS), true); }
        else if (kind == 7) {
            REPEAT(REP_UP) {
            const bool late = STAGGER && ((c.blk >> 3) & 1);
            if (!late) sample_mlp_up(c, L);
#ifdef REP_UPX
            REPEAT(REP_UPX) { pg8::Gemm g0{XB, (const bf16_t*)(c.ws + WS_WUP + L * WUP_STRIDE), M, FF, D}; pg8::StaticOrder S0; S0.init(M, FF, c.G, c.blk);
                pg8::EpiMlpUp E0{(const LAS float*)(c.lds + RSTAB_OFF), (bf16_t*)(c.ws + 700 * MiB), c.lds + EPISCR_OFF, c.lds, SS, c.blk, UPX_MODE}; pg8::gemm_phase<pg8::EpiMlpUp, pg8::StaticOrder, true, true>(c.lds, g0, S0, E0, c.wave); }
#endif
#ifdef REP_UPNULL
            REPEAT(REP_UPNULL) { pg8::Gemm g0{XB, (const bf16_t*)(c.ws + WS_WUP + L * WUP_STRIDE), M, FF, D}; pg8::StaticOrder S0; S0.init(M, FF, c.G, c.blk); pg8::EpiNull E0; pg8::gemm_phase<pg8::EpiNull, pg8::StaticOrder, true, true>(c.lds, g0, S0, E0, c.wave); }
#endif
            pg8::Gemm g{XB, (const bf16_t*)(c.ws + WS_WUP + L * WUP_STRIDE), M, FF, D}; pg8::StaticOrder S; S.init(M, FF, c.G, c.blk);
            pg8::EpiMlpUp E{(const LAS float*)(c.lds + RSTAB_OFF), (bf16_t*)(c.ws + WS_HB), c.lds + EPISCR_OFF, c.lds, SS, c.blk};
            pg8::gemm_phase<pg8::EpiMlpUp, pg8::StaticOrder, true, true>(c.lds, g, S, E, c.wave);
            if (late) sample_mlp_up(c, L); }
        }
        else { REPEAT(REP_FIN) phase_final(c); }
        if (ph_ + 1 < hi) { xcd_barrier(bar);
#ifdef REP_BAR
            xcd_barrier(bar);
#endif
        }
    }
}

extern "C" void kernel_launch(void* const* d_in, const int* in_sizes, int n_in, void* d_out, int out_size, void* d_ws, size_t ws_size, hipStream_t stream) {
    static int grid = 0;
    if (grid == 0) {
        if (n_in != 23 || in_sizes[0] != M * D || (size_t)out_size != O_END || ws_size < 900 * MiB) {
            fprintf(stderr, "kernel_launch: unexpected shapes (n_in %d, in0 %d, out %d, ws %zu); nothing launched\n", n_in, n_in > 0 ? in_sizes[0] : -1, out_size, ws_size); grid = -1; return; }
        int dev = 0, cus = 0, per_cu = 0;
        if (hipGetDevice(&dev) != hipSuccess || hipDeviceGetAttribute(&cus, hipDeviceAttributeMultiprocessorCount, dev) != hipSuccess) { fprintf(stderr, "kernel_launch: device query failed\n"); grid = -1; return; }
        if (hipFuncSetAttribute((const void*)hyb_fwd, hipFuncAttributeMaxDynamicSharedMemorySize, LDS_BYTES) != hipSuccess) { fprintf(stderr, "kernel_launch: hipFuncSetAttribute failed\n"); grid = -1; return; }
        if (hipOccupancyMaxActiveBlocksPerMultiprocessor(&per_cu, (const void*)hyb_fwd, NTHR, LDS_BYTES) != hipSuccess || per_cu < 1)
            fprintf(stderr, "kernel_launch: note: occupancy query reports %d workgroups per CU\n", per_cu);
        (void)hipGetLastError();
        grid = cus;
    }
    if (grid < 0) return;
    (void)hipMemsetAsync((char*)d_ws + WS_CTL, 0, CTL_ZERO_BYTES, stream);
    Args a{};
    for (int i = 0; i < 23; ++i) a.in[i] = (const float*)d_in[i];
    a.out = (float*)d_out; a.ws = (unsigned char*)d_ws;
#if MK_N_LAUNCHES == 1
    a.ph_lo = 0; a.ph_hi = NPHASE;
    hipLaunchKernelGGL(hyb_fwd, dim3(grid), dim3(NTHR), LDS_BYTES, stream, a);
#else
    for (int p = 0; p < NPHASE; ++p) { a.ph_lo = p; a.ph_hi = p + 1; hipLaunchKernelGGL(hyb_fwd, dim3(grid), dim3(NTHR), LDS_BYTES, stream, a); }
#endif
}
```

```cpp
#include <hip/hip_runtime.h>
#include <cstdio>
#include <cstdint>
#define MK_N_LAUNCHES 1
namespace pg8 {
#define PG8_LAS __attribute__((address_space(3)))
typedef unsigned short bf16_t;
typedef short bf16x8 __attribute__((ext_vector_type(8)));
typedef float f32x4 __attribute__((ext_vector_type(4)));
typedef unsigned u32x4 __attribute__((ext_vector_type(4)));
constexpr int BM = 256, BK = 64, HALF = 128, HTB = HALF * BK * 2  , STAGE_BYTES = 8 * HTB, NXCD = 8, WGM = 8;

__host__ __device__ __forceinline__ int lds_byte(int r, int c) { const int st = (r >> 4) * 2 + (c >> 5), rr = r & 15, cc = c & 31, ob = rr * 64 + cc * 2; return st * 1024 + (ob ^ (((ob >> 9) & 1) << 5)); }
__host__ __device__ __forceinline__ void stage_rc(int b, int& R, int& C) { const int st = b / 1024, sb = b % 1024, swz = sb ^ (((sb >> 9) & 1) << 5); R = (st >> 1) * 16 + swz / 64; C = (st & 1) * 32 + (swz % 64) / 2; }
__host__ __device__ __forceinline__ int perm32(int rho) { const int n = rho >> 4, i = rho & 15; return 8 * (i >> 2) + 4 * n + (i & 3); }

struct Unit { int pm, pn; };
struct Gemm { const bf16_t* A; const bf16_t* Bt; int M, N, K; };

struct StaticOrder {
    int nM, nN, nwg, G, c;
    __host__ __device__ void init(int M, int N, int G_, int c_) { nM = M / BM; nN = N / BM; nwg = nM * nN; G = G_; c = c_; }
    __host__ __device__ bool next(int i, Unit& u) const {
        const long L = (long)i * G + c; if (L >= nwg) return false;
        int wgid = (int)L; { const int q = nwg / NXCD, r = nwg % NXCD, xcd = wgid % NXCD, off = wgid / NXCD; wgid = (xcd < r ? xcd * (q + 1) : r * (q + 1) + (xcd - r) * q) + off; }
        const int nig = WGM * nN, gid = wgid / nig, fm = gid * WGM, gsz = (nM - fm) < WGM ? (nM - fm) : WGM;
        u.pm = fm + ((wgid % nig) % gsz); u.pn = (wgid % nig) / gsz; return true;
    }
    __device__ __forceinline__ void a_ready(const Unit&) const {}
    __device__ __forceinline__ void done(const Unit&) const {}
};
__device__ __forceinline__ unsigned cvt_pk_bf16(float lo, float hi) { unsigned r; asm volatile("v_cvt_pk_bf16_f32 %0, %1, %2" : "=v"(r) : "v"(lo), "v"(hi)); return r; }
typedef float f32x2 __attribute__((ext_vector_type(2)));
__device__ __forceinline__ f32x2 gelu_pk(f32x2 v) {
    const f32x2 av = __builtin_elementwise_abs(v), d = av * 0.2316418882f + 1.0f;
    f32x2 t; t.x = __builtin_amdgcn_rcpf(d.x); t.y = __builtin_amdgcn_rcpf(d.y);
    f32x2 q = t * 0.5307027145f + (-0.7265760135f); q = q * t + 0.7107068705f; q = q * t + (-0.142248368f); q = q * t + 0.127414796f; q = q * t;
    const f32x2 s = (v * v) * (-0.72134752044f);
    f32x2 e; e.x = __builtin_amdgcn_exp2f(s.x); e.y = __builtin_amdgcn_exp2f(s.y);
    const f32x2 m = v * (q * e), r = v - m;
    f32x2 o; o.x = v.x < 0.f ? m.x : r.x; o.y = v.y < 0.f ? m.y : r.y; return o;
}
template <class Epi, class Sched, bool ALIGN_EPI = false, bool SP2 = false, bool TILED_A = false>
__device__ __forceinline__ void gemm_phase(PG8_LAS unsigned char* lds, const Gemm g, const Sched& S, const Epi& E, const int wave_id) {
    unsigned ones_l = ~0u; asm volatile("" : "+s"(ones_l)); const int tid_l = wave_id * 64 + (int)__builtin_amdgcn_mbcnt_hi(ones_l, __builtin_amdgcn_mbcnt_lo(ones_l, 0u));
    const int tid = tid_l, wid = __builtin_amdgcn_readfirstlane(tid >> 6), lane = tid & 63, wr = wid >> 2, wc = wid & 3, fr = lane & 15, fq = lane >> 4;
    const int K = g.K, nt = K / BK;
    unsigned voffA[2], voffB[2];
#pragma unroll
    for (int i = 0; i < 2; ++i) { int R, C; stage_rc(tid * 16 + i * 8192, R, C); const int Rb = Epi::PERM ? ((R & ~31) + perm32(R & 31)) : R;
        voffA[i] = (unsigned)(R * (TILED_A ? BK : K) + C) * 2u; voffB[i] = (unsigned)(Rb * K + C) * 2u; }
    const size_t kstep = (size_t)(BK * 2);
    const size_t hstep = (size_t)HALF * K * 2;
    const size_t tstep = 2 * hstep;
    const size_t kstepA = TILED_A ? (size_t)(2 * HALF * BK * 2) : kstep, hstepA = TILED_A ? (size_t)(HALF * BK * 2) : hstep, tstepA = TILED_A ? (size_t)nt * (2 * HALF * BK * 2) : tstep;
    const unsigned ldsw = (unsigned)wid * 1024u;
    const int aoff = lds_byte(wr * 64 + fr, fq * 8), boff = lds_byte(wc * 32 + fr, fq * 8);
#define PG8_SA(b, h) (((b) * 2 + (h)) * HTB)
#define PG8_SB(b, h) ((4 + (b) * 2 + (h)) * HTB)
#define PG8_STAGE(bufoff, gbase, voff) do { _Pragma("unroll") for (int _i = 0; _i < 2; ++_i) \
        __builtin_amdgcn_global_load_lds((const unsigned*)((const char*)(gbase) + (voff)[_i]), (PG8_LAS unsigned*)(lds + (bufoff) + ldsw + _i * 8192), 16, 0, 0); } while (0)
#define PG8_LDA(dst, b, h) do { _Pragma("unroll") for (int m = 0; m < 4; ++m) _Pragma("unroll") for (int k = 0; k < 2; ++k) dst[m][k] = *(const PG8_LAS bf16x8*)(lds + PG8_SA(b, h) + aoff + m * 2048 + k * 1024); } while (0)
#define PG8_LDB(dst, b, h) do { _Pragma("unroll") for (int n = 0; n < 2; ++n) _Pragma("unroll") for (int k = 0; k < 2; ++k) dst[n][k] = *(const PG8_LAS bf16x8*)(lds + PG8_SB(b, h) + boff + n * 2048 + k * 1024); } while (0)
#define PG8_MMA(ai, bj, At, Bt) do { __builtin_amdgcn_s_setprio(1); _Pragma("unroll") for (int m = 0; m < 4; ++m) _Pragma("unroll") for (int n = 0; n < 2; ++n) _Pragma("unroll") for (int k = 0; k < 2; ++k) \
        acc[ai][bj][m][n] = __builtin_amdgcn_mfma_f32_16x16x32_bf16(Bt[n][k], At[m][k], acc[ai][bj][m][n], 0, 0, 0); __builtin_amdgcn_s_setprio(0); } while (0)
#define PG8_WAIT_V(n) asm volatile("s_waitcnt vmcnt(" #n ")" ::: "memory")
#define PG8_WAIT_L(n) asm volatile("s_waitcnt lgkmcnt(" #n ")" ::: "memory")
#define PG8_BAR __builtin_amdgcn_s_barrier()
#define PG8_SCHED __builtin_amdgcn_sched_barrier(0)
    Unit cur, nxt; int ui = 0;
    if (!S.next(0, cur)) return;
    f32x4 acc[2][2][4][2];
#pragma unroll
    for (int a = 0; a < 2; ++a)
#pragma unroll
        for (int b = 0; b < 2; ++b)
#pragma unroll
            for (int m = 0; m < 4; ++m)
#pragma unroll
                for (int n = 0; n < 2; ++n) acc[a][b][m][n] = (f32x4){0.f, 0.f, 0.f, 0.f};
    bf16x8 At[4][2], B0[2][2], B1[2][2];
    const char* cA = (const char*)g.A + (size_t)cur.pm * tstepA; const char* cB = (const char*)g.Bt + (size_t)cur.pn * tstep;
    S.a_ready(cur);
    if constexpr (SP2) {
        PG8_STAGE(PG8_SB(0, 0), cB, voffB); PG8_STAGE(PG8_SB(0, 1), cB + hstep, voffB); PG8_STAGE(PG8_SA(0, 0), cA, voffA); PG8_STAGE(PG8_SA(0, 1), cA + hstepA, voffA);
        E.pre(tid);
        if (wr == 1) PG8_BAR;
        PG8_WAIT_V(2); PG8_BAR;
        PG8_STAGE(PG8_SB(1, 0), cB + kstep, voffB); PG8_STAGE(PG8_SA(1, 0), cA + kstepA, voffA); PG8_STAGE(PG8_SB(1, 1), cB + hstep + kstep, voffB);
        PG8_WAIT_V(6); PG8_BAR;
    } else {
        PG8_STAGE(PG8_SB(0, 0), cB, voffB); PG8_STAGE(PG8_SA(0, 0), cA, voffA); PG8_STAGE(PG8_SB(0, 1), cB + hstep, voffB); PG8_STAGE(PG8_SA(0, 1), cA + hstepA, voffA);
        E.pre(tid);
        if (wr == 1) PG8_BAR;
        PG8_WAIT_V(4); PG8_BAR;
        PG8_STAGE(PG8_SB(1, 0), cB + kstep, voffB); PG8_STAGE(PG8_SA(1, 0), cA + kstepA, voffA); PG8_STAGE(PG8_SB(1, 1), cB + hstep + kstep, voffB);
        PG8_WAIT_V(6); PG8_BAR;
    }
    for (;;) {
        const bool has_next = S.next(ui + 1, nxt);
        const char* nA = has_next ? (const char*)g.A + (size_t)nxt.pm * tstepA : cA; const char* nB = has_next ? (const char*)g.Bt + (size_t)nxt.pn * tstep : cB;
        for (int t = 0; t < nt; t += 2) {
if constexpr (Epi::KHOOK) { asm volatile("" : "+v"(voffA[0]), "+v"(voffA[1]), "+v"(voffB[0]), "+v"(voffB[1])); }
            if constexpr (Epi::KHOOK) E.khook(acc, t, wr, fr);
            const bool last = (t == nt - 2);
            const char* a1 = cA + (size_t)(t + 1) * kstepA;
            const char* a2 = last ? nA : cA + (size_t)(t + 2) * kstepA; const char* b2 = last ? nB : cB + (size_t)(t + 2) * kstep;
            const char* a3 = a2 + kstepA; const char* b3 = b2 + kstep;
            if (last && has_next) S.a_ready(nxt);
            if constexpr (SP2) {
            PG8_LDB(B0, 0, 0); PG8_LDB(B1, 0, 1); PG8_SCHED; PG8_LDA(At, 0, 0); PG8_STAGE(PG8_SA(1, 1), a1 + hstepA, voffA);
            PG8_WAIT_V(8); PG8_WAIT_L(0); PG8_BAR; PG8_MMA(0, 0, At, B0); PG8_MMA(0, 1, At, B1); PG8_BAR; PG8_SCHED;
            PG8_LDA(At, 0, 1); PG8_STAGE(PG8_SB(0, 0), b2, voffB); PG8_STAGE(PG8_SB(0, 1), b2 + hstep, voffB); PG8_STAGE(PG8_SA(0, 0), a2, voffA);
            PG8_WAIT_V(8); PG8_WAIT_L(0); PG8_BAR; PG8_MMA(1, 0, At, B0); PG8_MMA(1, 1, At, B1); PG8_BAR; PG8_SCHED;
            PG8_LDB(B0, 1, 0); PG8_LDB(B1, 1, 1); PG8_SCHED; PG8_LDA(At, 1, 0); PG8_STAGE(PG8_SA(0, 1), a2 + hstepA, voffA);
            PG8_WAIT_V(8); PG8_WAIT_L(0); PG8_BAR; PG8_MMA(0, 0, At, B0); PG8_MMA(0, 1, At, B1); PG8_BAR; PG8_SCHED;
            PG8_LDA(At, 1, 1); PG8_STAGE(PG8_SB(1, 0), b3, voffB); PG8_STAGE(PG8_SB(1, 1), b3 + hstep, voffB); PG8_STAGE(PG8_SA(1, 0), a3, voffA);
            PG8_WAIT_V(8); PG8_WAIT_L(0); PG8_BAR; PG8_MMA(1, 0, At, B0); PG8_MMA(1, 1, At, B1); PG8_BAR; PG8_SCHED;
            } else {
            PG8_LDB(B0, 0, 0); PG8_SCHED; PG8_LDA(At, 0, 0); PG8_STAGE(PG8_SA(1, 1), a1 + hstepA, voffA);
            PG8_WAIT_L(8); PG8_BAR; PG8_WAIT_L(0); PG8_MMA(0, 0, At, B0); PG8_BAR; PG8_SCHED;
            PG8_LDB(B1, 0, 1); PG8_STAGE(PG8_SB(0, 0), b2, voffB);
            PG8_BAR; PG8_WAIT_L(0); PG8_MMA(0, 1, At, B1); PG8_BAR;
            PG8_LDA(At, 0, 1); PG8_STAGE(PG8_SA(0, 0), a2, voffA);
            PG8_BAR; PG8_WAIT_L(0); PG8_MMA(1, 0, At, B0); PG8_BAR; PG8_SCHED;
            PG8_STAGE(PG8_SB(0, 1), b2 + hstep, voffB);
            PG8_WAIT_V(6); PG8_BAR; PG8_MMA(1, 1, At, B1); PG8_BAR;
            PG8_LDB(B0, 1, 0); PG8_SCHED; PG8_LDA(At, 1, 0); PG8_STAGE(PG8_SA(0, 1), a2 + hstepA, voffA);
            PG8_WAIT_L(8); PG8_BAR; PG8_WAIT_L(0); PG8_MMA(0, 0, At, B0); PG8_BAR; PG8_SCHED;
            PG8_LDB(B1, 1, 1); PG8_STAGE(PG8_SB(1, 0), b3, voffB);
            PG8_BAR; PG8_WAIT_L(0); PG8_MMA(0, 1, At, B1); PG8_BAR;
            PG8_LDA(At, 1, 1); PG8_STAGE(PG8_SA(1, 0), a3, voffA);
            PG8_BAR; PG8_WAIT_L(0); PG8_MMA(1, 0, At, B0); PG8_BAR; PG8_SCHED;
            PG8_STAGE(PG8_SB(1, 1), b3 + hstep, voffB);
            PG8_WAIT_V(6); PG8_BAR; PG8_MMA(1, 1, At, B1); PG8_BAR;
            }
        }
        if constexpr (ALIGN_EPI) { if (wr == 0) PG8_BAR; }
        if constexpr (!Epi::AFTER_DRAIN) { E(acc, cur, wr, wc, fr, fq); S.done(cur); }
        if (!has_next) break;
#pragma unroll
        for (int a = 0; a < 2; ++a)
#pragma unroll
            for (int b = 0; b < 2; ++b)
#pragma unroll
                for (int m = 0; m < 4; ++m)
#pragma unroll
                    for (int n = 0; n < 2; ++n) acc[a][b][m][n] = (f32x4){0.f, 0.f, 0.f, 0.f};
        cur = nxt; cA = nA; cB = nB; ++ui;
        if constexpr (ALIGN_EPI) { if (wr == 1) PG8_BAR; }
    }
    PG8_WAIT_V(0);
    if constexpr (!ALIGN_EPI) { if (wr == 0) PG8_BAR; }
    PG8_BAR;
    if constexpr (Epi::AFTER_DRAIN) { E.fused(acc, cur, wr, wc, fr, fq, lds, wid, lane); S.done(cur); }
#undef PG8_SA
#undef PG8_SB
#undef PG8_STAGE
#undef PG8_LDA
#undef PG8_LDB
#undef PG8_MMA
#undef PG8_WAIT_V
#undef PG8_WAIT_L
#undef PG8_BAR
#undef PG8_SCHED
}
}
#define LAS __attribute__((address_space(3)))
typedef unsigned short bf16_t;
typedef short bf16x8 __attribute__((ext_vector_type(8)));
typedef float f32x4 __attribute__((ext_vector_type(4)));
typedef float f32x2 __attribute__((ext_vector_type(2)));
typedef unsigned u32x4 __attribute__((ext_vector_type(4)));
typedef unsigned u32x2 __attribute__((ext_vector_type(2)));
typedef __bf16 bf16x2_t __attribute__((ext_vector_type(2)));

#ifndef MK_N_LAUNCHES
#define MK_N_LAUNCHES 1
#endif

constexpr int NWAVES = 8, NTHR = 512;
constexpr int M = 16384, MS = 128, SEQ = 2048, NB = 8, D = 1024;
constexpr int DI = 2048, NH = 32, HD = 64, NG = 8, HPG = 4, NST = 128, CONVD = 4096, INDIM = 6176, INMAIN = 6144;
constexpr int CW = 2048, FF = 4096, NCHUNK = 16, CH = 128;
constexpr size_t XC_BOFF = (size_t)NB * NH * SEQ * HD, XC_COFF = XC_BOFF + (size_t)NB * NG * SEQ * NST;
constexpr float EPS = 1e-5f;
constexpr int NPHASE = 24;

constexpr size_t O_Y = 0, O_YS = 16777216, O_SSMP = 16908288, O_CONVP = 21102592, O_SSMS = 21299200, O_CONVS = 88408064, O_CMV = 91553792, O_END = 92078080;

constexpr size_t MiB = 1u << 20;
constexpr size_t WS_CTL = 0, CTL_ZERO_BYTES = 1 * MiB;
constexpr size_t WS_WSI = 2 * MiB, WSI_STRIDE = 13 * MiB;
constexpr size_t WS_WSO = 28 * MiB, WSO_STRIDE = 4 * MiB;
constexpr size_t WS_WCI = 36 * MiB, WCI_STRIDE = 8 * MiB;
constexpr size_t WS_WCO = 52 * MiB, WCO_STRIDE = 4 * MiB;
constexpr size_t WS_WUP = 60 * MiB, WUP_STRIDE = 8 * MiB;
constexpr size_t WS_WDN = 92 * MiB, WDN_STRIDE = 8 * MiB;
constexpr size_t WS_X = 124 * MiB;
constexpr size_t WS_XB = 188 * MiB;
constexpr size_t WS_SS = 220 * MiB;
constexpr size_t WS_SSV = 221 * MiB;
constexpr size_t WS_DT = 223 * MiB;
constexpr size_t WS_SSY = 236 * MiB;
constexpr size_t WS_XS = 225 * MiB;
constexpr size_t WS_XSB = WS_XS + 512 * 1024;
constexpr size_t WS_SSS = WS_XSB + 256 * 1024;
constexpr size_t WS_SSVS = WS_SSS + 32 * 1024;
constexpr size_t WS_DTS = WS_SSVS + 64 * 1024;
constexpr size_t WS_ZSS = 226 * MiB;
constexpr size_t WS_XBCS = 227 * MiB;
constexpr size_t WS_YNS = 229 * MiB;
constexpr size_t WS_HS = 230 * MiB;
constexpr size_t WS_US = 231 * MiB;
constexpr size_t WS_GVS = 232 * MiB;
constexpr size_t WS_ZS = 240 * MiB;
constexpr size_t WS_XBC = 304 * MiB;
constexpr size_t WS_HPREV = 432 * MiB;
constexpr size_t WS_YN = 496 * MiB;
constexpr size_t WS_HB = 560 * MiB;
constexpr size_t WS_XC = 688 * MiB;
constexpr size_t WS_END = 816 * MiB;
constexpr int CW_BAR = 4096;

constexpr int LDS_BYTES = 160 * 1024;
constexpr int LDSCTL_OFF = LDS_BYTES - 512;
constexpr int TP = 272;

#define LDS_WAIT() asm volatile("s_waitcnt lgkmcnt(0)" ::: "memory")
#define VM_WAIT() asm volatile("s_waitcnt vmcnt(0)" ::: "memory")
__device__ __forceinline__ unsigned pkbf(float lo, float hi) { f32x2 v = {lo, hi}; bf16x2_t b = __builtin_convertvector(v, bf16x2_t); return __builtin_bit_cast(unsigned, b); }
__device__ __forceinline__ float bf_lo(unsigned w) { return __uint_as_float(w << 16); }
__device__ __forceinline__ float bf_hi(unsigned w) { return __uint_as_float(w & 0xffff0000u); }
__device__ __forceinline__ float bf1(bf16_t h) { return __uint_as_float(((unsigned)h) << 16); }
__device__ __forceinline__ float exp_f(float x) { return __builtin_amdgcn_exp2f(x * 1.4426950408889634f); }
__device__ __forceinline__ float silu_f(float v) { return v * __builtin_amdgcn_rcpf(1.f + __builtin_amdgcn_exp2f(-1.4426950408889634f * v)); }
__device__ __forceinline__ float softplus_f(float x) { return x > 20.f ? x : log1pf(expf(x)); }
__device__ __forceinline__ float wave_sum(float v) {
#pragma unroll
    for (int o = 1; o < 64; o <<= 1) v += __shfl_xor(v, o);
    return v;
}
#define LDS_BARRIER() do { asm volatile("s_waitcnt lgkmcnt(0)" ::: "memory"); __builtin_amdgcn_s_barrier(); asm volatile("" ::: "memory"); } while (0)
__device__ __forceinline__ int lane_id_fresh() { unsigned ones = ~0u; asm volatile("" : "+s"(ones)); return (int)__builtin_amdgcn_mbcnt_hi(ones, __builtin_amdgcn_mbcnt_lo(ones, 0u)); }
__host__ __device__ __forceinline__ int phys256(int c) { return (c & ~255) | (((c >> 5) & 3) << 6) | (((c >> 7) & 1) << 5) | (c & 31); }
__host__ __device__ __forceinline__ int log256(int c) { return (c & ~255) | (((c >> 5) & 1) << 7) | (((c >> 6) & 3) << 5) | (c & 31); }
constexpr int EPISCR_OFF = 132096, EPISCR_PITCH = 144, EPISCR_WAVE = 16 * 144;
__host__ __device__ __forceinline__ size_t frag_off(int row, int k, int K) { return ((size_t)((row >> 4) * (K >> 5) + (k >> 5)) * 64 + (((k >> 3) & 3) * 16 + (row & 15))) * 8 + (k & 7); }
__device__ __forceinline__ float dot4(f32x4 a) { return (a.x * a.x + a.y * a.y) + (a.z * a.z + a.w * a.w); }
__device__ __forceinline__ float row_rstd(const float* ss, int ns4, int row, float inv_n) {
    const f32x4* p = (const f32x4*)(ss + (size_t)row * ns4 * 4); float s = 0.f;
    for (int i = 0; i < ns4; ++i) { const f32x4 v = p[i]; s += (v.x + v.y) + (v.z + v.w); }
    return rsqrtf(s * inv_n + EPS);
}

constexpr int RSTAB_OFF = 131072;
__device__ __forceinline__ int panel_of(int c) { return 8 * (c & 7) + ((c >> 3) & 7); }
__device__ __forceinline__ void fill_rstd_table(LAS unsigned char* lds, const float* SS, int blk, int tid) {
    if (tid < 256) ((LAS float*)(lds + RSTAB_OFF))[tid] = row_rstd(SS, 4, panel_of(blk) * 256 + tid, 1.f / 1024.f);
    asm volatile("s_waitcnt lgkmcnt(0)" ::: "memory");
}

constexpr int RGTAB_OFF = RSTAB_OFF + 1024;
constexpr int RG7_OFF = RGTAB_OFF + 16384;
__device__ __forceinline__ void fill_group_table(LAS unsigned char* lds, const float* SSY, int blk, int tid) {
    if (tid < 256) { const f32x4* p = (const f32x4*)(SSY + ((size_t)panel_of(blk) * 256 + tid) * 32); float s[8];
#pragma unroll
        for (int g = 0; g < 8; ++g) { const f32x4 v = p[g]; s[g] = rsqrtf(((v.x + v.y) + (v.z + v.w)) * (1.f / 256.f) + EPS); }
        LAS float* o = (LAS float*)(lds + RGTAB_OFF) + tid;
#pragma unroll
        for (int i = 0; i < 16; ++i) o[i * 256] = ((i & 1) == 0 && i > 0) ? s[(i >> 1) - 1] / s[i >> 1] : 1.f;
        ((LAS float*)(lds + RG7_OFF))[tid] = s[7]; }
    asm volatile("s_waitcnt lgkmcnt(0)" ::: "memory");
}

#ifndef WT_STORES
#define WT_STORES 1
#endif
__device__ __forceinline__ void st_wt(bf16_t* base, unsigned bytes, size_t off_elems, u32x4 v) {
#if WT_STORES
    __builtin_amdgcn_raw_buffer_store_b128(v, __builtin_amdgcn_make_buffer_rsrc(base, 0, bytes, 0x00020000), (int)(off_elems * 2), 0, 16);
#else
    *(u32x4*)(base + off_elems) = v;
#endif
}

namespace pg8 {
struct EpiResid {
    static constexpr bool PERM = true, AFTER_DRAIN = false, KHOOK = false;
    __device__ __forceinline__ void pre(int tid) const {  }
    bf16_t* XB; float* SS;
    __device__ __forceinline__ void operator()(const f32x4 (&acc)[2][2][4][2], const Unit& u, int wr, int wc, int fr, int fq) const {
        const int row0 = u.pm * BM + wr * 64 + fr, col0 = u.pn * BM + wc * 32 + 8 * fq;
        u32x4 pre2[2][4][2];
#pragma unroll
        for (int ai = 0; ai < 2; ++ai)
#pragma unroll
            for (int m = 0; m < 4; ++m)
#pragma unroll
                for (int bj = 0; bj < 2; ++bj) pre2[ai][m][bj] = *(const u32x4*)(XB + (size_t)(row0 + ai * HALF + m * 16) * 1024 + col0 + bj * HALF);
#pragma unroll
        for (int ai = 0; ai < 2; ++ai) {
#pragma unroll
            for (int m = 0; m < 4; ++m) { const int row = row0 + ai * HALF + m * 16; float ss = 0.f;
#pragma unroll
                for (int bj = 0; bj < 2; ++bj) { const size_t off = (size_t)row * 1024 + col0 + bj * HALF; const u32x4 p = pre2[ai][m][bj];
                    const f32x4 v0 = acc[ai][bj][m][0] + (f32x4){::bf_lo(p.x), ::bf_hi(p.x), ::bf_lo(p.y), ::bf_hi(p.y)}, v1 = acc[ai][bj][m][1] + (f32x4){::bf_lo(p.z), ::bf_hi(p.z), ::bf_lo(p.w), ::bf_hi(p.w)};
                    u32x4 w; w.x = ::pkbf(v0[0], v0[1]); w.y = ::pkbf(v0[2], v0[3]); w.z = ::pkbf(v1[0], v1[1]); w.w = ::pkbf(v1[2], v1[3]);
                    ::st_wt(XB, 16384u * 1024u * 2u, off, w); ss += ::dot4(v0) + ::dot4(v1); }
                ss += __shfl_xor(ss, 16); ss += __shfl_xor(ss, 32);
                if (fq == 0) SS[(size_t)row * 16 + u.pn * 4 + wc] = ss; }
            asm volatile("" ::: "memory");
        }
    }
};
struct EpiResidG {
    static constexpr bool PERM = true, AFTER_DRAIN = false, KHOOK = true;
    bf16_t* XB; float* SS; const LAS float* RG; LAS unsigned char* ldsb; const float* SSY; int blk;
    __device__ __forceinline__ void pre(int tid) const { fill_group_table(ldsb, SSY, blk, tid); }
    __device__ __forceinline__ void khook(f32x4 (&acc)[2][2][4][2], int t, int wr, int fr) const {
        const LAS float* rg = RG + (t >> 1) * 256 + wr * 64 + fr;
#pragma unroll
        for (int ai = 0; ai < 2; ++ai)
#pragma unroll
            for (int m = 0; m < 4; ++m) { const float rt = rg[ai * HALF + m * 16];
#pragma unroll
                for (int bj = 0; bj < 2; ++bj) { acc[ai][bj][m][0] = acc[ai][bj][m][0] * rt; acc[ai][bj][m][1] = acc[ai][bj][m][1] * rt; } }
    }
    __device__ __forceinline__ void operator()(const f32x4 (&acc)[2][2][4][2], const Unit& u, int wr, int wc, int fr, int fq) const {
        const int row0 = u.pm * BM + wr * 64 + fr, col0 = u.pn * BM + wc * 32 + 8 * fq;
        u32x4 pre2[2][4][2];
#pragma unroll
        for (int ai = 0; ai < 2; ++ai)
#pragma unroll
            for (int m = 0; m < 4; ++m)
#pragma unroll
                for (int bj = 0; bj < 2; ++bj) pre2[ai][m][bj] = *(const u32x4*)(XB + (size_t)(row0 + ai * HALF + m * 16) * 1024 + col0 + bj * HALF);
#pragma unroll
        for (int ai = 0; ai < 2; ++ai) {
#pragma unroll
            for (int m = 0; m < 4; ++m) { const int row = row0 + ai * HALF + m * 16; float ss = 0.f; const float s7 = RG[4096 + wr * 64 + fr + ai * HALF + m * 16];
#pragma unroll
                for (int bj = 0; bj < 2; ++bj) { const size_t off = (size_t)row * 1024 + col0 + bj * HALF; const u32x4 p = pre2[ai][m][bj];
                    const f32x4 v0 = acc[ai][bj][m][0] * s7 + (f32x4){::bf_lo(p.x), ::bf_hi(p.x), ::bf_lo(p.y), ::bf_hi(p.y)}, v1 = acc[ai][bj][m][1] * s7 + (f32x4){::bf_lo(p.z), ::bf_hi(p.z), ::bf_lo(p.w), ::bf_hi(p.w)};
                    u32x4 w; w.x = ::pkbf(v0[0], v0[1]); w.y = ::pkbf(v0[2], v0[3]); w.z = ::pkbf(v1[0], v1[1]); w.w = ::pkbf(v1[2], v1[3]);
                    ::st_wt(XB, 16384u * 1024u * 2u, off, w); ss += ::dot4(v0) + ::dot4(v1); }
                ss += __shfl_xor(ss, 16); ss += __shfl_xor(ss, 32);
                if (fq == 0) SS[(size_t)row * 16 + u.pn * 4 + wc] = ss; }
            asm volatile("" ::: "memory");
        }
    }
};
struct EpiSsdIn {
    static constexpr bool PERM = true, AFTER_DRAIN = false, KHOOK = false;
    const LAS float* RS; bf16_t* ZS; bf16_t* XBC; float* convst; LAS unsigned char* scr; LAS unsigned char* ldsb; const float* SSp; int blk;
    __device__ __forceinline__ void pre(int tid) const { fill_rstd_table(ldsb, SSp, blk, tid); }
    __device__ __forceinline__ void operator()(const f32x4 (&acc)[2][2][4][2], const Unit& u, int wr, int wc, int fr, int fq) const {
        const int row0 = u.pm * BM + wr * 64 + fr, col0 = u.pn * BM + wc * 32 + 8 * fq; const bool isz = u.pn < 8;
        LAS unsigned char* sw = scr + (wr * 4 + wc) * EPISCR_WAVE; const int lane = fq * 16 + fr, rrow = lane >> 3, rchunk = lane & 7;
        bf16_t* dst = isz ? ZS : XBC; const int ldd = isz ? 2048 : 4096; const unsigned nbytes = isz ? 16384u * 2048u * 2u : 16384u * 4096u * 2u;
        const size_t gbase = (size_t)(u.pm * BM + wr * 64 + rrow) * ldd + (isz ? u.pn * BM : u.pn * BM - 2048) + wc * 64 + rchunk * 8;
#pragma unroll
        for (int ai = 0; ai < 2; ++ai)
#pragma unroll
            for (int m = 0; m < 4; ++m) { const int row = row0 + ai * HALF + m * 16; const float rs = RS[wr * 64 + fr + ai * HALF + m * 16];
#pragma unroll
                for (int bj = 0; bj < 2; ++bj) { const int c = col0 + bj * HALF; f32x4 v0 = acc[ai][bj][m][0] * rs, v1 = acc[ai][bj][m][1] * rs; u32x4 w;
                    if (isz) { w.x = ::pkbf(::silu_f(v0[0]), ::silu_f(v0[1])); w.y = ::pkbf(::silu_f(v0[2]), ::silu_f(v0[3])); w.z = ::pkbf(::silu_f(v1[0]), ::silu_f(v1[1])); w.w = ::pkbf(::silu_f(v1[2]), ::silu_f(v1[3])); }
                    else { w.x = ::pkbf(v0[0], v0[1]); w.y = ::pkbf(v0[2], v0[3]); w.z = ::pkbf(v1[0], v1[1]); w.w = ::pkbf(v1[2], v1[3]);
                        const int t = row & 2047;
                        if (t >= 2045) { float* o = convst + ((size_t)(row >> 11) * 3 + (t - 2045)) * 4096 + c - 2048; *(f32x4*)o = v0; *(f32x4*)(o + 4) = v1; } }
                    *(LAS u32x4*)(sw + fr * EPISCR_PITCH + bj * 64 + fq * 16) = w; }
#pragma unroll
                for (int hh = 0; hh < 2; ++hh) { const u32x4 w = *(const LAS u32x4*)(sw + (hh * 8 + rrow) * EPISCR_PITCH + rchunk * 16);
                    ::st_wt(dst, nbytes, gbase + (size_t)(ai * HALF + m * 16 + hh * 8) * ldd, w); } }
    }
};
struct EpiMlpUp {
    static constexpr bool PERM = true, AFTER_DRAIN = false, KHOOK = false;
    const LAS float* RS; bf16_t* HB; LAS unsigned char* scr; LAS unsigned char* ldsb; const float* SSp; int blk; int mode = 0;
    __device__ __forceinline__ void pre(int tid) const { fill_rstd_table(ldsb, SSp, blk, tid); }
    __device__ __forceinline__ void operator()(const f32x4 (&acc)[2][2][4][2], const Unit& u, int wr, int wc, int fr, int fq) const {
        LAS unsigned char* sw = scr + (wr * 4 + wc) * EPISCR_WAVE; const int lane = fq * 16 + fr;
        const int rrow = lane >> 3, rchunk = lane & 7;
        const size_t gbase = ((size_t)(u.pm * 64 + u.pn * 4 + wc) * BM + wr * 64 + rrow) * 64 + rchunk * 8;
#pragma unroll
        for (int ai = 0; ai < 2; ++ai)
#pragma unroll
            for (int m = 0; m < 4; ++m) { const float rs = RS[wr * 64 + fr + ai * HALF + m * 16];
#pragma unroll
                for (int bj = 0; bj < 2; ++bj) { f32x4 v0 = acc[ai][bj][m][0] * rs, v1 = acc[ai][bj][m][1] * rs;
#pragma unroll
                    for (int e = 0; e < 4; ++e) { const float a = fmaxf(v0[e], 0.f), b = fmaxf(v1[e], 0.f); v0[e] = a * a; v1[e] = b * b; }
                    u32x4 w; w.x = ::pkbf(v0[0], v0[1]); w.y = ::pkbf(v0[2], v0[3]); w.z = ::pkbf(v1[0], v1[1]); w.w = ::pkbf(v1[2], v1[3]);
                    *(LAS u32x4*)(sw + fr * EPISCR_PITCH + bj * 64 + fq * 16) = w; }
#pragma unroll
                for (int hh = 0; hh < 2; ++hh) { const u32x4 w = *(const LAS u32x4*)(sw + (hh * 8 + rrow) * EPISCR_PITCH + rchunk * 16);
                    if (mode == 0) ::st_wt(HB, 16384u * 4096u * 2u, gbase + (size_t)(ai * HALF + m * 16 + hh * 8) * 64, w); else if (mode == 2) *(u32x4*)(HB + gbase + (size_t)(ai * HALF + m * 16 + hh * 8) * 64) = w; else asm volatile("" :: "v"(w.x), "v"(w.y), "v"(w.z), "v"(w.w)); } }
    }
};
struct EpiCmIn {
    static constexpr bool PERM = true, AFTER_DRAIN = false, KHOOK = false;
    const LAS float* RS; const float* bias; bf16_t* U; bf16_t* GV; float* SSV; LAS unsigned char* scr; LAS unsigned char* ldsb; const float* SSp; int blk;
    __device__ __forceinline__ void pre(int tid) const { fill_rstd_table(ldsb, SSp, blk, tid); }
    __device__ __forceinline__ void operator()(const f32x4 (&acc)[2][2][4][2], const Unit& u, int wr, int wc, int fr, int fq) const {
        const int row0 = u.pm * BM + wr * 64 + fr, col0 = u.pn * BM + wc * 32 + 8 * fq; const bool isu = u.pn < 8;
        LAS unsigned char* sw = scr + (wr * 4 + wc) * EPISCR_WAVE; const int lane = fq * 16 + fr, rrow = lane >> 3, rchunk = lane & 7;
        bf16_t* dst = isu ? U : GV;
        const size_t gbase = isu ? ((size_t)(u.pm * 32 + u.pn * 4 + wc) * BM + wr * 64 + rrow) * 64 + rchunk * 8
                                 : ((size_t)(((2 * u.pm) * 8 + (u.pn - 8)) * 2 + (wc >> 1)) * 128 + wr * 64 + rrow) * 128 + (wc & 1) * 64 + rchunk * 8;
        const size_t aist = isu ? (size_t)HALF * 64 : (size_t)8 * 2 * 128 * 128; const int rst = isu ? 64 : 128;
        f32x4 bv[2][2];
#pragma unroll
        for (int bj = 0; bj < 2; ++bj) { bv[bj][0] = *(const f32x4*)(bias + col0 + bj * HALF); bv[bj][1] = *(const f32x4*)(bias + col0 + bj * HALF + 4); }
#pragma unroll
        for (int ai = 0; ai < 2; ++ai)
#pragma unroll
            for (int m = 0; m < 4; ++m) { const int row = row0 + ai * HALF + m * 16; const float rs = RS[wr * 64 + fr + ai * HALF + m * 16]; float ss = 0.f;
#pragma unroll
                for (int bj = 0; bj < 2; ++bj) { f32x4 v0 = acc[ai][bj][m][0] * rs + bv[bj][0], v1 = acc[ai][bj][m][1] * rs + bv[bj][1];
                    const f32x2 a = gelu_pk((f32x2){v0[0], v0[1]}), b = gelu_pk((f32x2){v0[2], v0[3]}), c = gelu_pk((f32x2){v1[0], v1[1]}), d = gelu_pk((f32x2){v1[2], v1[3]});
                    u32x4 w; w.x = ::pkbf(a.x, a.y); w.y = ::pkbf(b.x, b.y); w.z = ::pkbf(c.x, c.y); w.w = ::pkbf(d.x, d.y);
                    *(LAS u32x4*)(sw + fr * EPISCR_PITCH + bj * 64 + fq * 16) = w;
                    if (!isu) ss += (a.x * a.x + a.y * a.y) + (b.x * b.x + b.y * b.y) + (c.x * c.x + c.y * c.y) + (d.x * d.x + d.y * d.y); }
#pragma unroll
                for (int hh = 0; hh < 2; ++hh) { const u32x4 w = *(const LAS u32x4*)(sw + (hh * 8 + rrow) * EPISCR_PITCH + rchunk * 16);
                    ::st_wt(dst, 16384u * 2048u * 2u, gbase + ai * aist + (size_t)(m * 16 + hh * 8) * rst, w); }
                if (!isu) { ss += __shfl_xor(ss, 16); ss += __shfl_xor(ss, 32); if (fq == 0) SSV[(size_t)row * 32 + (u.pn - 8) * 4 + wc] = ss; } }
    }
};
struct EpiNull {
    static constexpr bool PERM = true, AFTER_DRAIN = false, KHOOK = false;
    __device__ __forceinline__ void pre(int tid) const {  }
    __device__ __forceinline__ void operator()(const f32x4 (&acc)[2][2][4][2], const Unit& u, int wr, int wc, int fr, int fq) const {
#pragma unroll
        for (int ai = 0; ai < 2; ++ai)
#pragma unroll
            for (int bj = 0; bj < 2; ++bj)
#pragma unroll
                for (int m = 0; m < 4; ++m)
#pragma unroll
                    for (int n = 0; n < 2; ++n) asm volatile("" :: "v"(acc[ai][bj][m][n]));
    }
};
}

template <int MT, int STEPS, bool AFRAG> __device__ __forceinline__ f32x4 block_gemm_ks(int wave, int lane, const bf16_t* A, int lda, int row_base, const bf16_t* Wt, int K, int col0, LAS float* red) {
    const int fr = lane & 15, fq = lane >> 4, ksl = K >> 3, nsteps = ksl >> 5;
    const bf16x8* ap = AFRAG ? (const bf16x8*)A + ((size_t)(row_base >> 4) * (K >> 5) + wave * (ksl >> 5)) * 64 + lane
                             : (const bf16x8*)(A + (size_t)(row_base + fr) * lda + wave * ksl + 8 * fq);
    const bf16x8* bp = (const bf16x8*)(Wt + (size_t)(col0 + fr) * K + wave * ksl + 8 * fq);
    const size_t mstride = AFRAG ? (size_t)(K >> 5) * 64 : (size_t)16 * lda / 8; const int sstride = AFRAG ? 64 : 4;
    f32x4 acc[MT];
#pragma unroll
    for (int m = 0; m < MT; ++m) acc[m] = (f32x4){0.f, 0.f, 0.f, 0.f};
    LDS_BARRIER();
#pragma unroll 1
    for (int s0 = 0; s0 < nsteps; s0 += STEPS) {
        bf16x8 bfr[STEPS], afr[MT][STEPS];
#pragma unroll
        for (int s = 0; s < STEPS; ++s) { bfr[s] = bp[4 * (s0 + s)];
#pragma unroll
            for (int m = 0; m < MT; ++m) afr[m][s] = ap[m * mstride + sstride * (s0 + s)]; }
#pragma unroll
        for (int s = 0; s < STEPS; ++s)
#pragma unroll
            for (int m = 0; m < MT; ++m) acc[m] = __builtin_amdgcn_mfma_f32_16x16x32_bf16(bfr[s], afr[m][s], acc[m], 0, 0, 0);
    }
#pragma unroll
    for (int m = 0; m < MT; ++m) *(LAS f32x4*)(red + ((wave * MT + m) * 64 + lane) * 4) = acc[m];
    LDS_BARRIER();
    f32x4 v = (f32x4){0.f, 0.f, 0.f, 0.f};
    if (wave < MT) {
#pragma unroll
        for (int w2 = 0; w2 < 8; ++w2) v = v + *(const LAS f32x4*)(red + ((w2 * MT + wave) * 64 + lane) * 4);
    }
    return v;
}

__device__ __forceinline__ void block_gemm_ks2(int wave, int lane, const bf16_t* A, const bf16_t* Wt, int K, int col0, LAS float* red, f32x4& o0, f32x4& o1) {
    const int fr = lane & 15, fq = lane >> 4, ksl = K >> 3, nsteps = ksl >> 5;
    const bf16x8* ap = (const bf16x8*)A + ((size_t)wave * (ksl >> 5)) * 64 + lane;
    const bf16x8* bp0 = (const bf16x8*)(Wt + (size_t)(col0 + fr) * K + wave * ksl + 8 * fq); const bf16x8* bp1 = (const bf16x8*)(Wt + (size_t)(col0 + 16 + fr) * K + wave * ksl + 8 * fq);
    const size_t mstride = (size_t)(K >> 5) * 64;
    f32x4 acc[8][2];
#pragma unroll
    for (int m = 0; m < 8; ++m) { acc[m][0] = (f32x4){0.f, 0.f, 0.f, 0.f}; acc[m][1] = acc[m][0]; }
    LDS_BARRIER();
#pragma unroll 1
    for (int s0 = 0; s0 < nsteps; s0 += 2) {
        bf16x8 b0[2], b1[2], afr[8][2];
#pragma unroll
        for (int s = 0; s < 2; ++s) { b0[s] = bp0[4 * (s0 + s)]; b1[s] = bp1[4 * (s0 + s)];
#pragma unroll
            for (int m = 0; m < 8; ++m) afr[m][s] = ap[m * mstride + 64 * (s0 + s)]; }
#pragma unroll
        for (int s = 0; s < 2; ++s)
#pragma unroll
            for (int m = 0; m < 8; ++m) { acc[m][0] = __builtin_amdgcn_mfma_f32_16x16x32_bf16(b0[s], afr[m][s], acc[m][0], 0, 0, 0); acc[m][1] = __builtin_amdgcn_mfma_f32_16x16x32_bf16(b1[s], afr[m][s], acc[m][1], 0, 0, 0); }
    }
#pragma unroll
    for (int m = 0; m < 8; ++m) { *(LAS f32x4*)(red + (((wave * 8 + m) * 2 + 0) * 64 + lane) * 4) = acc[m][0]; *(LAS f32x4*)(red + (((wave * 8 + m) * 2 + 1) * 64 + lane) * 4) = acc[m][1]; }
    LDS_BARRIER();
    o0 = (f32x4){0.f, 0.f, 0.f, 0.f}; o1 = o0;
#pragma unroll
    for (int w2 = 0; w2 < 8; ++w2) { o0 = o0 + *(const LAS f32x4*)(red + (((w2 * 8 + wave) * 2 + 0) * 64 + lane) * 4); o1 = o1 + *(const LAS f32x4*)(red + (((w2 * 8 + wave) * 2 + 1) * 64 + lane) * 4); }
}

#define PHASE_CTX(c0) Ctx c = (c0); c.lane = lane_id_fresh(); c.tid = c.wave * 64 + c.lane
struct Ctx {
    const float* in[23]; float* out; unsigned char* ws;
    LAS unsigned char* lds; int tid, lane, wave, blk, G;
};

struct TrItem { const float* W; bf16_t* WT; const float* gk; int K, N, k0, n0, perm; };
__device__ __forceinline__ TrItem tr_decode(const Ctx& c, int it) {
    constexpr int I_SI = 16 * 193, I_SO = 32 * 32, I_CI = 16 * 128, I_CO = 32 * 32, I_UP = 16 * 128, I_DN = 64 * 32;
    constexpr int NITEMS_BEFORE_DN = 2 * I_SI + 2 * I_SO + 2 * I_CI + 2 * I_CO + 4 * I_UP;
    constexpr int NITEMS_BEFORE_CO = 2 * I_SI + 2 * I_SO + 2 * I_CI;
    TrItem t; int r = it, j;
    if (r < 2 * I_SI) { j = r / I_SI; r -= j * I_SI; t.W = c.in[7] + (size_t)j * 1024 * INDIM; t.K = 1024; t.N = INDIM; t.WT = (bf16_t*)(c.ws + WS_WSI + j * WSI_STRIDE); t.gk = c.in[4] + (2 * j) * 1024; }
    else if ((r -= 2 * I_SI) < 2 * I_SO) { j = r / I_SO; r -= j * I_SO; t.W = c.in[14] + (size_t)j * 2048 * 1024; t.K = 2048; t.N = 1024; t.WT = (bf16_t*)(c.ws + WS_WSO + j * WSO_STRIDE); t.gk = c.in[13] + j * 2048; }
    else if ((r -= 2 * I_SO) < 2 * I_CI) { j = r / I_CI; r -= j * I_CI; t.W = c.in[15] + (size_t)j * 1024 * 4096; t.K = 1024; t.N = 4096; t.WT = (bf16_t*)(c.ws + WS_WCI + j * WCI_STRIDE); t.gk = c.in[4] + (2 * j + 1) * 1024; }
    else if ((r -= 2 * I_CI) < 2 * I_CO) { j = r / I_CO; r -= j * I_CO; t.W = c.in[20] + (size_t)j * 2048 * 1024; t.K = 2048; t.N = 1024; t.WT = (bf16_t*)(c.ws + WS_WCO + j * WCO_STRIDE); t.gk = nullptr; }
    else if ((r -= 2 * I_CO) < 4 * I_UP) { j = r / I_UP; r -= j * I_UP; t.W = c.in[21] + (size_t)j * 1024 * 4096; t.K = 1024; t.N = 4096; t.WT = (bf16_t*)(c.ws + WS_WUP + j * WUP_STRIDE); t.gk = c.in[5] + j * 1024; }
    else { r -= 4 * I_UP; j = r / I_DN; r -= j * I_DN; t.W = c.in[22] + (size_t)j * 4096 * 1024; t.K = 4096; t.N = 1024; t.WT = (bf16_t*)(c.ws + WS_WDN + j * WDN_STRIDE); t.gk = nullptr; }
    const int nblk = t.N / 32; t.k0 = 64 * (r / nblk); t.n0 = 32 * (r % nblk); t.perm = (it >= NITEMS_BEFORE_DN || (it >= NITEMS_BEFORE_CO && it < NITEMS_BEFORE_CO + 2 * I_CO)) ? 1 : 0; return t;
}
__device__ __forceinline__ void tr_load(const TrItem& t, int lane, f32x4 (&v)[8], f32x4 (&gv)[2]) {
    const float* p = t.W + t.n0 + 4 * (lane & 7);
#pragma unroll
    for (int i = 0; i < 8; ++i) { const int kp = t.k0 + (lane >> 3) + 8 * i; v[i] = *(const f32x4*)(p + (size_t)(t.perm ? log256(kp) : kp) * t.N); }
    if (t.gk) { gv[0] = *(const f32x4*)(t.gk + t.k0 + 8 * (lane & 7)); gv[1] = *(const f32x4*)(t.gk + t.k0 + 8 * (lane & 7) + 4); }
    else { gv[0] = (f32x4){1.f, 1.f, 1.f, 1.f}; gv[1] = gv[0]; }
}
__device__ __forceinline__ void row_to_bf16_ss(const float* xrow, bf16_t* orow, float* ssrow, int nslots, int lane, int frag_row = -1) {
    const f32x4* xr = (const f32x4*)xrow + lane; float s = 0.f; f32x4 v[4];
#pragma unroll
    for (int j = 0; j < 4; ++j) { v[j] = xr[64 * j]; s += dot4(v[j]); }
    s = wave_sum(s);
#pragma unroll
    for (int j = 0; j < 4; ++j) { u32x2 w; w.x = pkbf(v[j].x, v[j].y); w.y = pkbf(v[j].z, v[j].w); const int col = 4 * lane + 256 * j; *(u32x2*)(orow + (frag_row >= 0 ? frag_off(frag_row, col, 1024) : (size_t)col)) = w; }
    for (int i = lane; i < nslots; i += 64) ssrow[i] = (i == 0) ? s : 0.f;
}

__device__ __forceinline__ void phase_prologue(const Ctx& c0) {
    PHASE_CTX(c0);
    LAS float* scr = (LAS float*)(c.lds + c.wave * 16384);
    const int gw = c.blk * NWAVES + c.wave, NGW = c.G * NWAVES;
    constexpr int NITEMS = 2 * (16 * 193) + 2 * (32 * 32) + 2 * (16 * 128) + 2 * (32 * 32) + 4 * (16 * 128) + 4 * (64 * 32);
    for (int m = gw; m < M + MS; m += NGW) {
        if (m < M) row_to_bf16_ss(c.in[0] + (size_t)m * D, (bf16_t*)(c.ws + WS_XB) + (size_t)m * D, (float*)(c.ws + WS_SS) + (size_t)m * 16, 16, c.lane);
        else { const int r = m - M; row_to_bf16_ss(c.in[1] + (size_t)r * D, (bf16_t*)(c.ws + WS_XSB), (float*)(c.ws + WS_SSS) + (size_t)r * 64, 64, c.lane, r); }
    }
    int it = gw; asm volatile("" : "+s"(it));
    if (it < NITEMS) {
        TrItem cur = tr_decode(c, it); f32x4 v[8], gv[2]; tr_load(cur, c.lane, v, gv);
#pragma unroll 1
        for (;;) {
#pragma unroll
            for (int i = 0; i < 8; ++i) { LAS float* s = scr + ((c.lane >> 3) + 8 * i) * 33 + 4 * (c.lane & 7); s[0] = v[i].x; s[1] = v[i].y; s[2] = v[i].z; s[3] = v[i].w; }
            const f32x4 g0 = gv[0], g1 = gv[1]; const TrItem t = cur;
            LDS_WAIT(); asm volatile("" ::: "memory");
            const int nxt = it + NGW; const bool more = nxt < NITEMS;
            if (more) { cur = tr_decode(c, nxt); tr_load(cur, c.lane, v, gv); }
            const int cc = c.lane & 7;
#pragma unroll
            for (int jn = 0; jn < 4; ++jn) { const int n = (c.lane >> 3) + 8 * jn; const LAS float* s = scr + (8 * cc) * 33 + n;
                u32x4 o; o.x = pkbf(s[0 * 33] * g0.x, s[1 * 33] * g0.y); o.y = pkbf(s[2 * 33] * g0.z, s[3 * 33] * g0.w); o.z = pkbf(s[4 * 33] * g1.x, s[5 * 33] * g1.y); o.w = pkbf(s[6 * 33] * g1.z, s[7 * 33] * g1.w);
                *(u32x4*)(t.WT + (size_t)(t.n0 + n) * t.K + t.k0 + 8 * cc) = o; }
            LDS_WAIT(); asm volatile("" ::: "memory");
            if (!more) break;
            it = nxt;
        }
    }
}

__device__ __forceinline__ void phase_conv(const Ctx& c0, int j) {
    PHASE_CTX(c0);
    const bf16_t* XBC = (const bf16_t*)(c.ws + WS_XBC); bf16_t* XC = (bf16_t*)(c.ws + WS_XC);
    const float* cw = c.in[8] + (size_t)j * 4 * CONVD; const float* cb = c.in[9] + (size_t)j * CONVD;
    LAS float* xs = (LAS float*)c.lds;
    LAS float* yb = xs + 512;
    LAS float* hd = xs + 768;
    LAS float* zb = xs + 784;
    const int w = c.wave;
    const float* XBCS = (const float*)(c.ws + WS_XBCS); const float* DTS = (const float*)(c.ws + WS_DTS); const float* ZSS = (const float*)(c.ws + WS_ZSS);
    bf16_t* YNS = (bf16_t*)(c.ws + WS_YNS);
    const float* cst_in = c.in[3] + (size_t)j * MS * 3 * CONVD; float* cst_out = c.out + O_CONVS + (size_t)j * MS * 3 * CONVD;
    const float* st_in = c.in[2] + (size_t)j * MS * NH * HD * NST; float* st_out = c.out + O_SSMS + (size_t)j * MS * NH * HD * NST;
#define SAMPLE_CONV(sit) do { const int sb_ = (sit) >> 3, g_ = (sit) & 7, t_ = c.tid; \
        const int ch_ = t_ < 256 ? g_ * 256 + t_ : (t_ < 384 ? 2048 + g_ * 128 + (t_ - 256) : 3072 + g_ * 128 + (t_ - 384)); \
        const float* ci_ = cst_in + (size_t)sb_ * 3 * CONVD + ch_; const float c0_ = ci_[0], c1_ = ci_[CONVD], c2_ = ci_[2 * CONVD], xn_ = XBCS[(size_t)sb_ * CONVD + ch_]; \
        xs[t_] = silu_f(cb[ch_] + cw[ch_] * c0_ + cw[CONVD + ch_] * c1_ + cw[2 * CONVD + ch_] * c2_ + cw[3 * CONVD + ch_] * xn_); \
        float* co_ = cst_out + (size_t)sb_ * 3 * CONVD + ch_; co_[0] = c1_; co_[CONVD] = c2_; co_[2 * CONVD] = xn_; \
        if (t_ < 256) zb[t_] = ZSS[(size_t)sb_ * DI + g_ * 256 + t_]; \
        if (t_ < 4) { const int h_ = 4 * g_ + t_; const float dt_ = DTS[sb_ * 32 + h_]; hd[t_] = dt_; hd[4 + t_] = expf(dt_ * -expf(c.in[11][j * NH + h_])); hd[8 + t_] = c.in[12][j * NH + h_]; } } while (0)
    for (int item = c.blk; item < NB * 32; item += c.G) {
        const int bb = item >> 5, rb = item & 31, ch = 8 * c.tid;
        const bf16_t* src = XBC + ((size_t)bb * SEQ + rb * 64) * CONVD + phys256(ch);
        const int xrs = ch < 2048 ? 64 : 128;
        bf16_t* dstp = XC + (ch < 2048 ? ((size_t)(bb * NH + (ch >> 6)) * SEQ + rb * 64) * 64 + (ch & 63)
                                     : (ch < 3072 ? XC_BOFF : XC_COFF) + ((size_t)(bb * NG + (((ch - 2048) & 1023) >> 7)) * SEQ + rb * 64) * 128 + (ch & 127));
        f32x4 wv[4][2], bia[2], win[3][2];
#pragma unroll
        for (int k = 0; k < 4; ++k) { wv[k][0] = *(const f32x4*)(cw + k * CONVD + ch); wv[k][1] = *(const f32x4*)(cw + k * CONVD + ch + 4); }
        bia[0] = *(const f32x4*)(cb + ch); bia[1] = *(const f32x4*)(cb + ch + 4);
#pragma unroll
        for (int i = 0; i < 3; ++i) { u32x4 r = (u32x4){0u, 0u, 0u, 0u}; if (rb > 0) r = *(const u32x4*)(src + (ptrdiff_t)(i - 3) * CONVD);
            win[i][0] = (f32x4){bf_lo(r.x), bf_hi(r.x), bf_lo(r.y), bf_hi(r.y)}; win[i][1] = (f32x4){bf_lo(r.z), bf_hi(r.z), bf_lo(r.w), bf_hi(r.w)}; }
        SAMPLE_CONV(item * 4);
        f32x4 st[4];
        { const int sit0 = item * 4, ssb0 = sit0 >> 3, sh0 = 4 * (sit0 & 7); const size_t sb0 = (((size_t)ssb0 * NH + sh0) * HD + 8 * w + (c.lane >> 5)) * NST + 4 * (c.lane & 31);
#pragma unroll
          for (int i = 0; i < 4; ++i) st[i] = *(const f32x4*)(st_in + sb0 + (size_t)(2 * i) * NST); }
        u32x4 rawn[4];
#pragma unroll
        for (int i = 0; i < 4; ++i) rawn[i] = *(const u32x4*)(src + (size_t)i * CONVD);
        LDS_BARRIER();
#pragma unroll 1
        for (int ck = 0; ck < 16; ++ck) {
            u32x4 raw[4];
#pragma unroll
            for (int i = 0; i < 4; ++i) raw[i] = rawn[i];
            if (ck + 1 < 16) {
#pragma unroll
                for (int i = 0; i < 4; ++i) rawn[i] = *(const u32x4*)(src + (size_t)(4 * (ck + 1) + i) * CONVD); }
            { const int sit = item * 4 + (ck >> 2), ssb = sit >> 3, sg = sit & 7, r = ck & 3, sh = 4 * sg + r, half = c.lane >> 5, nq = c.lane & 31;
              const size_t sbase = (((size_t)ssb * NH + sh) * HD + 8 * w + half) * NST + 4 * nq;
              const float dt = hd[r], dA = hd[4 + r], Dsh = hd[8 + r];
              const f32x4 B4 = *(const LAS f32x4*)(xs + 256 + 4 * nq), C4 = *(const LAS f32x4*)(xs + 384 + 4 * nq);
#pragma unroll
              for (int i = 0; i < 4; ++i) { const int p = 8 * w + 2 * i + half; const float xp = xs[r * 64 + p];
                  const f32x4 hn = st[i] * dA + B4 * (dt * xp);
                  *(f32x4*)(st_out + sbase + (size_t)(2 * i) * NST) = hn;
                  float part = (C4.x * hn.x + C4.y * hn.y) + (C4.z * hn.z + C4.w * hn.w);
                  part += __shfl_xor(part, 1); part += __shfl_xor(part, 2); part += __shfl_xor(part, 4); part += __shfl_xor(part, 8); part += __shfl_xor(part, 16);
                  if (nq == 0) yb[r * 64 + p] = (part + Dsh * xp) * zb[r * 64 + p]; }
              if (ck + 1 < 16) { const int sit1 = item * 4 + ((ck + 1) >> 2), ssb1 = sit1 >> 3, sh1 = 4 * (sit1 & 7) + ((ck + 1) & 3); const size_t sb1 = (((size_t)ssb1 * NH + sh1) * HD + 8 * w + half) * NST + 4 * nq;
#pragma unroll
                  for (int i = 0; i < 4; ++i) st[i] = *(const f32x4*)(st_in + sb1 + (size_t)(2 * i) * NST); } }
#pragma unroll
            for (int i = 0; i < 4; ++i) { const u32x4 r = raw[i];
                const f32x4 c0v = (f32x4){bf_lo(r.x), bf_hi(r.x), bf_lo(r.y), bf_hi(r.y)}, c1v = (f32x4){bf_lo(r.z), bf_hi(r.z), bf_lo(r.w), bf_hi(r.w)};
                f32x4 o0 = bia[0] + wv[0][0] * win[0][0] + wv[1][0] * win[1][0] + wv[2][0] * win[2][0] + wv[3][0] * c0v;
                f32x4 o1 = bia[1] + wv[0][1] * win[0][1] + wv[1][1] * win[1][1] + wv[2][1] * win[2][1] + wv[3][1] * c1v;
                win[0][0] = win[1][0]; win[0][1] = win[1][1]; win[1][0] = win[2][0]; win[1][1] = win[2][1]; win[2][0] = c0v; win[2][1] = c1v;
                u32x4 q; q.x = pkbf(silu_f(o0[0]), silu_f(o0[1])); q.y = pkbf(silu_f(o0[2]), silu_f(o0[3])); q.z = pkbf(silu_f(o1[0]), silu_f(o1[1])); q.w = pkbf(silu_f(o1[2]), silu_f(o1[3]));
                *(u32x4*)(dstp + (size_t)(4 * ck + i) * xrs) = q; }
            LDS_BARRIER();
            if ((ck & 3) == 3) {
                const int sit = item * 4 + (ck >> 2), ssb = sit >> 3, sg = sit & 7;
                const f32x4 yv4 = *(const LAS f32x4*)(yb + 4 * c.lane); const float tot = wave_sum(dot4(yv4)); const float rs = rsqrtf(tot * (1.f / 256.f) + EPS);
                if (c.lane < 16) { const int i2 = w * 32 + 2 * c.lane; *(unsigned*)(YNS + frag_off(ssb, sg * 256 + i2, DI)) = pkbf(yb[i2] * rs, yb[i2 + 1] * rs); }
                if (ck + 1 < 16) SAMPLE_CONV(sit + 1);
            }
            LDS_BARRIER();
        }
    }
#undef SAMPLE_CONV
}

__device__ __forceinline__ u32x4 tr8_col(const u32x4 (&raw)[8], int jj) {
    unsigned e[8];
#pragma unroll
    for (int i = 0; i < 8; ++i) { const unsigned wd = (jj >> 1) == 0 ? raw[i].x : ((jj >> 1) == 1 ? raw[i].y : ((jj >> 1) == 2 ? raw[i].z : raw[i].w)); e[i] = (jj & 1) ? (wd >> 16) : (wd & 0xffffu); }
    u32x4 o; o.x = e[0] | (e[1] << 16); o.y = e[2] | (e[3] << 16); o.z = e[4] | (e[5] << 16); o.w = e[6] | (e[7] << 16); return o;
}

typedef short v4i16_t __attribute__((ext_vector_type(4)));
__device__ __forceinline__ bf16x8 lds_tr_frag(const LAS unsigned char* tile, int pitch, int k0, int n0, int lane) {
    const int g = lane >> 4, q = (lane & 15) >> 2, p = lane & 3;
    const LAS unsigned char* a = tile + (k0 + 8 * g + q) * pitch + (n0 + 4 * p) * 2;
    const v4i16_t lo = __builtin_amdgcn_ds_read_tr16_b64_v4i16((LAS v4i16_t*)a);
    const v4i16_t hi = __builtin_amdgcn_ds_read_tr16_b64_v4i16((LAS v4i16_t*)(a + 4 * pitch));
    return (bf16x8){lo[0], lo[1], lo[2], lo[3], hi[0], hi[1], hi[2], hi[3]};
}
__device__ __forceinline__ void phase_ssd_scan(const Ctx& c0, int j) {
    PHASE_CTX(c0);
    const bf16_t* XC = (const bf16_t*)(c.ws + WS_XC); const float* DT = (const float*)(c.ws + WS_DT); const bf16_t* ZS = (const bf16_t*)(c.ws + WS_ZS);
    bf16_t* YN = (bf16_t*)(c.ws + WS_YN); float* SSY = (float*)(c.ws + WS_SSY);
    constexpr int XP = 144;
    LAS unsigned char* RC = c.lds;
    LAS unsigned char* RB = c.lds + 34816;
    LAS unsigned char* RX = c.lds + 69632;
    LAS unsigned char* RX2 = c.lds + 88064;
    LAS unsigned char* RH = c.lds + 106496;
    LAS float* scl = (LAS float*)(c.lds + 123904);
    const int w = c.wave;
    const int rt = (w < 4) ? w : 11 - w;
    for (int item_ = c.blk; item_ < NB * NH; item_ += c.G) {
        const int item = ((item_ & 7) << 5) | (item_ >> 3);
        const int bb = item >> 5, h = item & 31, g = h >> 2;
        const float Ah = -expf(c.in[11][j * NH + h]), Dh = c.in[12][j * NH + h];
        f32x4 hs[4];
#pragma unroll
        for (int t = 0; t < 4; ++t) hs[t] = (f32x4){0.f, 0.f, 0.f, 0.f};
        const int pt = w & 3, nt0 = 4 * (w >> 2);
        u32x4 ncp[4], nbp[4], nxp[4]; u32x2 nzz[4]; float nd0 = 0.f, nd1 = 0.f;
#define STAGE_LOADS(ck) do { \
            _Pragma("unroll") for (int i = 0; i < 4; ++i) { const int pc_ = c.tid + 512 * i, rw_ = pc_ >> 4, cc_ = pc_ & 15; \
                ncp[i] = *(const u32x4*)(XC + XC_COFF + ((size_t)(bb * NG + g) * SEQ + (ck) * CH + rw_) * 128 + cc_ * 8); nbp[i] = *(const u32x4*)(XC + XC_BOFF + ((size_t)(bb * NG + g) * SEQ + (ck) * CH + rw_) * 128 + cc_ * 8); } \
            if (w < 4) { _Pragma("unroll") for (int i = 0; i < 4; ++i) { const int px_ = c.tid + 256 * i, rw_ = px_ >> 3, cc_ = px_ & 7; nxp[i] = *(const u32x4*)(XC + ((size_t)(bb * NH + h) * SEQ + (ck) * CH + rw_) * 64 + cc_ * 8); } } \
            { const int q_ = 16 * rt + (c.lane & 15); _Pragma("unroll") for (int p4 = 0; p4 < 4; ++p4) nzz[p4] = *(const u32x2*)(ZS + ((size_t)bb * SEQ + (ck) * CH + q_) * DI + phys256(h * 64 + 16 * p4 + 4 * (c.lane >> 4))); } \
            if (w == 1) { const float* dp_ = DT + ((size_t)bb * SEQ + (ck) * CH + 2 * c.lane) * 32 + h; nd0 = dp_[0]; nd1 = dp_[32]; } } while (0)
#define SSD_SCALE(ck) do { const int s0 = 2 * c.lane; const float d0 = nd0, d1 = nd1; const float a0 = d0 * Ah, a1 = d1 * Ah; float run = a0 + a1; \
            _Pragma("unroll") for (int o = 1; o < 64; o <<= 1) { const float t_ = __shfl_up(run, o); if (c.lane >= o) run += t_; } \
            const float tot = __shfl(run, 63); const float ac1 = run, ac0 = run - a1; \
            LAS float* sb_ = scl + ((ck) & 1) * 400; sb_[s0] = ac0; sb_[s0 + 1] = ac1; sb_[128 + s0] = d0; sb_[128 + s0 + 1] = d1; \
            sb_[256 + s0] = d0 * exp_f(tot - ac0); sb_[256 + s0 + 1] = d1 * exp_f(tot - ac1); if (c.lane == 0) sb_[384] = exp_f(tot); } while (0)
        STAGE_LOADS(0);
        if (w == 1) SSD_SCALE(0);
        __syncthreads();
        for (int ck = 0; ck < NCHUNK; ++ck) {
            { int lz_ = c.lane; asm volatile("" : "+v"(lz_)); c.lane = lz_; c.tid = w * 64 + lz_; }
            const int fr = c.lane & 15, fq = c.lane >> 4, q = 16 * rt + fr;
            const LAS float* sb = scl + (ck & 1) * 400;
            const size_t row0 = (size_t)bb * SEQ + ck * CH;
#pragma unroll
            for (int i = 0; i < 4; ++i) { const int pc = c.tid + 512 * i, rw = pc >> 4, cc = pc & 15; *(LAS u32x4*)(RC + rw * TP + cc * 16) = ncp[i]; *(LAS u32x4*)(RB + rw * TP + cc * 16) = nbp[i]; }
            if (w < 4) {
#pragma unroll
                for (int i = 0; i < 4; ++i) { const int px = c.tid + 256 * i, rw = px >> 3, cc = px & 7; const u32x4 r = nxp[i]; const float sc = sb[256 + rw];
                    *(LAS u32x4*)(RX + rw * XP + cc * 16) = r;
                    u32x4 s4; s4.x = pkbf(bf_lo(r.x) * sc, bf_hi(r.x) * sc); s4.y = pkbf(bf_lo(r.y) * sc, bf_hi(r.y) * sc); s4.z = pkbf(bf_lo(r.z) * sc, bf_hi(r.z) * sc); s4.w = pkbf(bf_lo(r.w) * sc, bf_hi(r.w) * sc);
                    *(LAS u32x4*)(RX2 + rw * XP + cc * 16) = s4; } }
#pragma unroll
            for (int t = 0; t < 4; ++t) { u32x2 o; o.x = pkbf(hs[t][0], hs[t][1]); o.y = pkbf(hs[t][2], hs[t][3]); *(LAS u32x2*)(RH + (16 * pt + fr) * TP + (16 * (nt0 + t) + 4 * fq) * 2) = o; }
            __syncthreads();
            u32x2 zz[4];
#pragma unroll
            for (int p4 = 0; p4 < 4; ++p4) zz[p4] = nzz[p4];
            if (ck + 1 < NCHUNK) STAGE_LOADS(ck + 1);
            bf16x8 cfr[4];
#pragma unroll
            for (int ks = 0; ks < 4; ++ks) cfr[ks] = *(const LAS bf16x8*)(RC + q * TP + (32 * ks + 8 * fq) * 2);
            f32x4 ao[4];
#pragma unroll
            for (int p4 = 0; p4 < 4; ++p4) { ao[p4] = (f32x4){0.f, 0.f, 0.f, 0.f};
#pragma unroll
                for (int ks = 0; ks < 4; ++ks) { const bf16x8 hf = *(const LAS bf16x8*)(RH + (16 * p4 + fr) * TP + (32 * ks + 8 * fq) * 2); ao[p4] = __builtin_amdgcn_mfma_f32_16x16x32_bf16(hf, cfr[ks], ao[p4], 0, 0, 0); } }
            const float aq = sb[q];
            const int npm1 = rt >> 1;
            {
                bf16x8 b0[4], b1[4]; f32x4 as0, ds0, as1, ds1;
#define SCAN_LOADP(u_) do { _Pragma("unroll") for (int ks = 0; ks < 4; ++ks) { b0[ks] = *(const LAS bf16x8*)(RB + (32 * (u_) + fr) * TP + (32 * ks + 8 * fq) * 2); b1[ks] = *(const LAS bf16x8*)(RB + (32 * (u_) + 16 + fr) * TP + (32 * ks + 8 * fq) * 2); } \
                    as0 = *(const LAS f32x4*)(sb + 32 * (u_) + 4 * fq); as1 = *(const LAS f32x4*)(sb + 32 * (u_) + 16 + 4 * fq); ds0 = *(const LAS f32x4*)(sb + 128 + 32 * (u_) + 4 * fq); ds1 = *(const LAS f32x4*)(sb + 128 + 32 * (u_) + 16 + 4 * fq); } while (0)
                SCAN_LOADP(0);
#pragma unroll 1
                for (int u = 0; ; ++u) {
                    f32x4 c0 = (f32x4){0.f, 0.f, 0.f, 0.f}, c1 = c0;
#pragma unroll
                    for (int ks = 0; ks < 4; ++ks) { c0 = __builtin_amdgcn_mfma_f32_16x16x32_bf16(b0[ks], cfr[ks], c0, 0, 0, 0); c1 = __builtin_amdgcn_mfma_f32_16x16x32_bf16(b1[ks], cfr[ks], c1, 0, 0, 0); }
                    const f32x4 a0 = as0, d0 = ds0, a1 = as1, d1 = ds1;
                    const bool lastp = (u == npm1);
                    if (!lastp) SCAN_LOADP(u + 1);
                    float l0[4], l1[4];
#pragma unroll
                    for (int e = 0; e < 4; ++e) { const int s = 32 * u + 4 * fq + e;
                        const float v0 = c0[e] * exp_f(fminf(aq - a0[e], 0.f)) * d0[e], v1 = c1[e] * exp_f(fminf(aq - a1[e], 0.f)) * d1[e];
                        l0[e] = (s <= q) ? v0 : 0.f; l1[e] = (s + 16 <= q) ? v1 : 0.f; }
                    u32x2 o0, o1; o0.x = pkbf(l0[0], l0[1]); o0.y = pkbf(l0[2], l0[3]); o1.x = pkbf(l1[0], l1[1]); o1.y = pkbf(l1[2], l1[3]);
                    *(LAS u32x2*)(RC + q * TP + (32 * u + 4 * fq) * 2) = o0; *(LAS u32x2*)(RC + q * TP + (32 * u + 16 + 4 * fq) * 2) = o1;
                    if (lastp) break;
                }
#undef SCAN_LOADP
            }
            f32x4 ay[4];
#pragma unroll
            for (int p4 = 0; p4 < 4; ++p4) ay[p4] = (f32x4){0.f, 0.f, 0.f, 0.f};
            {
                bf16x8 lfc, xc[4], lfn, xn[4];
#define SCAN_LOADY(ks_, lf_, x_) do { lf_ = *(const LAS bf16x8*)(RC + q * TP + (32 * (ks_) + 8 * fq) * 2); _Pragma("unroll") for (int p4 = 0; p4 < 4; ++p4) x_[p4] = lds_tr_frag(RX, XP, 32 * (ks_), 16 * p4, c.lane); } while (0)
                SCAN_LOADY(0, lfc, xc);
#pragma unroll 1
                for (int ks = 0; ; ++ks) {
                    const bool lastk = (ks == npm1);
                    const int kn = lastk ? ks : ks + 1;
                    SCAN_LOADY(kn, lfn, xn);
#pragma unroll
                    for (int p4 = 0; p4 < 4; ++p4) ay[p4] = __builtin_amdgcn_mfma_f32_16x16x32_bf16(xc[p4], lfc, ay[p4], 0, 0, 0);
                    if (lastk) break;
                    lfc = lfn;
#pragma unroll
                    for (int p4 = 0; p4 < 4; ++p4) xc[p4] = xn[p4];
                }
#undef SCAN_LOADY
            }
            const float eq = exp_f(aq); float ssq = 0.f;
#pragma unroll
            for (int p4 = 0; p4 < 4; ++p4) {
                const int pc = 16 * p4 + 4 * fq; const float zf[4] = {bf_lo(zz[p4].x), bf_hi(zz[p4].x), bf_lo(zz[p4].y), bf_hi(zz[p4].y)}; float yv[4];
                const u32x2 xr = *(const LAS u32x2*)(RX + q * XP + pc * 2); const float xf4[4] = {bf_lo(xr.x), bf_hi(xr.x), bf_lo(xr.y), bf_hi(xr.y)};
#pragma unroll
                for (int e = 0; e < 4; ++e) { const float y = (ay[p4][e] + eq * ao[p4][e] + Dh * xf4[e]) * zf[e]; yv[e] = y; ssq += y * y; }
                u32x2 o; o.x = pkbf(yv[0], yv[1]); o.y = pkbf(yv[2], yv[3]); *(u32x2*)(YN + ((size_t)(((row0 + q) >> 8) * 32 + h) * 256 + ((row0 + q) & 255)) * 64 + pc) = o;
            }
            ssq += __shfl_xor(ssq, 16); ssq += __shfl_xor(ssq, 32);
            if (fq == 0) SSY[(row0 + q) * 32 + h] = ssq;
            {
                f32x4 S[4];
#pragma unroll
                for (int t = 0; t < 4; ++t) S[t] = (f32x4){0.f, 0.f, 0.f, 0.f};
#pragma unroll
                for (int ks = 0; ks < 4; ++ks) { const bf16x8 a = lds_tr_frag(RX2, XP, 32 * ks, 16 * pt, c.lane);
#pragma unroll
                    for (int t = 0; t < 4; ++t) { const bf16x8 b2 = lds_tr_frag(RB, TP, 32 * ks, 16 * (nt0 + t), c.lane); S[t] = __builtin_amdgcn_mfma_f32_16x16x32_bf16(b2, a, S[t], 0, 0, 0); } }
                const float cdec = sb[384];
#pragma unroll
                for (int t = 0; t < 4; ++t) hs[t] = hs[t] * cdec + S[t];
            }
            if (w == 1 && ck + 1 < NCHUNK) SSD_SCALE(ck + 1);
            __syncthreads();
        }
#undef SSD_SCALE
#undef STAGE_LOADS
        { int lz = c.lane; asm volatile("" : "+v"(lz));
          float* so = c.out + O_SSMP + ((((size_t)j * NB + bb) * NH + h) * HD + 16 * pt + (lz & 15)) * NST + 16 * nt0 + 4 * (lz >> 4);
#pragma unroll
          for (int t = 0; t < 4; ++t) *(f32x4*)(so + 16 * t) = hs[t]; }
    }
}

__device__ __forceinline__ void phase_cm_mix(const Ctx& c0, int j, bf16_t* Uout, bool do_sample) {
    PHASE_CTX(c0);
    const bf16_t* U = (const bf16_t*)(c.ws + WS_ZS); const bf16_t* GV = (const bf16_t*)(c.ws + WS_XBC); const float* SSV = (const float*)(c.ws + WS_SSV);
    const float* vg = c.in[17] + (size_t)j * CW; const float* bs = c.in[19] + (size_t)j * NG * CH; const float* wsm = c.in[18] + (size_t)j * NG * CH * CH;
    LAS unsigned char* GT = c.lds;
    LAS float* rsv = (LAS float*)(c.lds + 104448);
    const int w = c.wave, rt = (w < 4) ? w : 11 - w, fr = c.lane & 15, fq = c.lane >> 4, q = 16 * rt + fr;
    if (do_sample && c.blk < MS) { const int row = c.blk; const float* GVS = (const float*)(c.ws + WS_GVS); bf16_t* US = (bf16_t*)(c.ws + WS_US);
        const float rs = row_rstd((const float*)(c.ws + WS_SSVS), 32, row, 1.f / 2048.f);
        const int d0 = 4 * c.tid, g = d0 >> 8; const f32x4 gv = *(const f32x4*)(GVS + (size_t)row * CW + d0), vgv = *(const f32x4*)(vg + d0);
        const f32x4 v = gv * rs * vgv; *(f32x4*)(c.out + O_CMV + ((size_t)j * MS + row) * CW + d0) = v;
        const float w00 = wsm[(size_t)g * CH * CH], b0 = bs[g * CH];
        const u32x2 uu = *(const u32x2*)(US + frag_off(row, phys256(d0), CW)); const f32x4 sv = v * w00 + b0;
        u32x2 o; o.x = pkbf(bf_lo(uu.x) * sv.x, bf_hi(uu.x) * sv.y); o.y = pkbf(bf_lo(uu.y) * sv.z, bf_hi(uu.y) * sv.w); *(u32x2*)(US + frag_off(row, phys256(d0), CW)) = o; }
    { const int k = c.tid >> 7, item = c.blk + k * c.G; if (item < NB * NCHUNK * NG) { const int rowk = (item >> 7) * SEQ + ((item >> 3) & 15) * CH + (c.tid & 127); rsv[c.tid] = row_rstd(SSV, 8, rowk, 1.f / 2048.f); } }
    __syncthreads();
    constexpr int NIT = NB * NCHUNK * NG;
    const int nh = c.blk < NIT ? 2 * ((NIT - 1 - c.blk) / c.G + 1) : 0;
    LAS unsigned char* usw = c.lds + 108544 + w * 4352;
    u32x4 raw[4], ur[4];
    float wfl[4][8]; bf16x8 wf[4]; float bq = 0.f; int gcur = -1;
#pragma unroll
    for (int ks = 0; ks < 4; ++ks) { wf[ks] = (bf16x8){0, 0, 0, 0, 0, 0, 0, 0};
#pragma unroll
        for (int e = 0; e < 8; ++e) wfl[ks][e] = 0.f; }
#define MIX_LOADS(hh) do { const int it_ = c.blk + ((hh) >> 1) * c.G, g_ = it_ & 7, hp_ = (hh) & 1; const size_t r0_ = (size_t)(it_ >> 7) * SEQ + ((it_ >> 3) & 15) * CH; \
        _Pragma("unroll") for (int i = 0; i < 4; ++i) { const int pid = c.tid + 512 * i; raw[i] = *(const u32x4*)(GV + ((size_t)(((it_ >> 3) * 8 + g_) * 2 + hp_) * 128) * 128 + pid * 8); } \
        _Pragma("unroll") for (int i = 0; i < 4; ++i) { const size_t rw_ = r0_ + 16 * rt + 4 * i + fq; ur[i] = *(const u32x4*)(U + ((size_t)((rw_ >> 8) * 32 + g_ * 4 + 2 * hp_ + (fr >> 3)) * 256 + (rw_ & 255)) * 64 + (fr & 7) * 8); } } while (0)
    if (nh > 0) MIX_LOADS(0);
#pragma unroll 1
    for (int h_ = 0; h_ < nh; ++h_) {
        int h = h_; asm volatile("" : "+s"(h));
        const int item = c.blk + (h >> 1) * c.G, hp = h & 1, g = item & 7;
        const size_t row0 = (size_t)(item >> 7) * SEQ + ((item >> 3) & 15) * CH;
        LAS unsigned char* gt = GT + (h & 1) * (128 * TP);
        if (hp == 0) {
            if (g != gcur) { gcur = g;
#pragma unroll
                for (int ks = 0; ks < 4; ++ks) { const int s0 = 32 * ks + 8 * fq; const float* wp = wsm + ((size_t)g * CH + q) * CH + s0; const f32x4 a = *(const f32x4*)wp, bb4 = *(const f32x4*)(wp + 4);
#pragma unroll
                    for (int e = 0; e < 4; ++e) { wfl[ks][e] = (s0 + e <= q) ? a[e] : 0.f; wfl[ks][4 + e] = (s0 + 4 + e <= q) ? bb4[e] : 0.f; } } }
            bq = bs[g * CH + q];
            const LAS float* rsk = rsv + ((h >> 1) & 3) * 128;
#pragma unroll
            for (int ks = 0; ks < 4; ++ks) { const f32x4 r0 = *(const LAS f32x4*)(rsk + 32 * ks + 8 * fq), r1 = *(const LAS f32x4*)(rsk + 32 * ks + 8 * fq + 4);
                u32x4 o; o.x = pkbf(wfl[ks][0] * r0[0], wfl[ks][1] * r0[1]); o.y = pkbf(wfl[ks][2] * r0[2], wfl[ks][3] * r0[3]); o.z = pkbf(wfl[ks][4] * r1[0], wfl[ks][5] * r1[1]); o.w = pkbf(wfl[ks][6] * r1[2], wfl[ks][7] * r1[3]);
                wf[ks] = __builtin_bit_cast(bf16x8, o); }
        }
#pragma unroll
        for (int i = 0; i < 4; ++i) { const int pid = c.tid + 512 * i; *(LAS u32x4*)(gt + (pid >> 4) * TP + (pid & 15) * 16) = raw[i]; }
#pragma unroll
        for (int i = 0; i < 4; ++i) *(LAS u32x4*)(usw + (4 * i + fq) * TP + fr * 16) = ur[i];
        asm volatile("s_waitcnt lgkmcnt(0)" ::: "memory"); __builtin_amdgcn_s_barrier(); asm volatile("" ::: "memory");
        if (h + 1 < nh) MIX_LOADS(h + 1);
        f32x4 vgvr[8];
#pragma unroll
        for (int k = 0; k < 8; ++k) { const int t = 8 * (k >> 2) + 4 * hp + (k & 3); vgvr[k] = *(const f32x4*)(vg + g * 256 + 16 * t + 4 * fq); }
        f32x4 acc[8];
#pragma unroll
        for (int k = 0; k < 8; ++k) acc[k] = (f32x4){0.f, 0.f, 0.f, 0.f};
#pragma unroll
        for (int ks = 0; ks < 4; ++ks) {
            if (ks <= (rt >> 1)) {
#pragma unroll
                for (int k = 0; k < 8; ++k) { const bf16x8 gf = lds_tr_frag(gt, TP, 32 * ks, 64 * ((k >> 1) & 1) + 32 * (k >> 2) + 16 * (k & 1), c.lane); acc[k] = __builtin_amdgcn_mfma_f32_16x16x32_bf16(gf, wf[ks], acc[k], 0, 0, 0); } } }
#pragma unroll
        for (int k = 0; k < 8; ++k) { const int so = (64 * ((k >> 1) & 1) + 32 * (k >> 2) + 16 * (k & 1) + 4 * fq) * 2;
            const u32x2 u2 = *(const LAS u32x2*)(usw + fr * TP + so); const f32x4 sv = acc[k] * vgvr[k] + bq;
            u32x2 o; o.x = pkbf(bf_lo(u2.x) * sv.x, bf_hi(u2.x) * sv.y); o.y = pkbf(bf_lo(u2.y) * sv.z, bf_hi(u2.y) * sv.w); *(LAS u32x2*)(usw + fr * TP + so) = o; }
#pragma unroll
        for (int i = 0; i < 4; ++i) { const u32x4 o4 = *(const LAS u32x4*)(usw + (4 * i + fq) * TP + fr * 16);
            const size_t rw = row0 + 16 * rt + 4 * i + fq; *(u32x4*)(Uout + ((size_t)((rw >> 8) * 32 + g * 4 + 2 * hp + (fr >> 3)) * 256 + (rw & 255)) * 64 + (fr & 7) * 8) = o4; }
    }
#undef MIX_LOADS
    __syncthreads();
}

__device__ __forceinline__ void sample_resid(const Ctx& c0, const bf16_t* A, int K, const bf16_t* Wt, const float* base, size_t dummy_off = 0) {
    PHASE_CTX(c0);
    float* XS = (float*)(c.ws + WS_XS + dummy_off); bf16_t* XSB = (bf16_t*)(c.ws + WS_XSB + dummy_off); float* SSS = (float*)(c.ws + WS_SSS + dummy_off);
    const int fr = c.lane & 15, fq = c.lane >> 4;
    for (int task = c.blk; task < 256; task += c.G) { const int tile = task & 63, rq = task >> 6;
        f32x4 bv = (f32x4){0.f, 0.f, 0.f, 0.f}; if (c.wave < 2) bv = *(const f32x4*)(base + (size_t)(32 * rq + 16 * c.wave + fr) * D + 16 * tile + 4 * fq);
        const f32x4 a = block_gemm_ks<2, 8, true>(c.wave, c.lane, A, K, 32 * rq, Wt, K, 16 * tile, (LAS float*)c.lds);
        if (c.wave < 2) { const int row = 32 * rq + 16 * c.wave + fr, col = 16 * tile + 4 * fq; const f32x4 v = a + bv;
            *(f32x4*)(XS + (size_t)row * D + col) = v; u32x2 o; o.x = pkbf(v.x, v.y); o.y = pkbf(v.z, v.w); *(u32x2*)(XSB + frag_off(row, col, D)) = o;
            float ss = dot4(v); ss += __shfl_xor(ss, 16); ss += __shfl_xor(ss, 32); if (fq == 0) SSS[row * 64 + tile] = ss; } }
    LDS_BARRIER();
}
__device__ __forceinline__ void sample_ssd_in(const Ctx& c0, int j) {
    PHASE_CTX(c0);
    const bf16_t* XSB = (const bf16_t*)(c.ws + WS_XSB); const float* SSS = (const float*)(c.ws + WS_SSS); const bf16_t* Wt = (const bf16_t*)(c.ws + WS_WSI + j * WSI_STRIDE);
    float* ZSS = (float*)(c.ws + WS_ZSS); float* XBCS = (float*)(c.ws + WS_XBCS); float* DTS = (float*)(c.ws + WS_DTS);
    const int fr = c.lane & 15, fq = c.lane >> 4; const int row = 16 * c.wave + fr; const float rs = row_rstd(SSS, 16, row, 1.f / 1024.f);
    for (int pair = c.blk; pair < INDIM / 32; pair += c.G) {
        f32x4 vv[2]; block_gemm_ks2(c.wave, c.lane, XSB, Wt, D, 32 * pair, (LAS float*)c.lds, vv[0], vv[1]);
#pragma unroll
        for (int e2 = 0; e2 < 2; ++e2) { f32x4 v = vv[e2] * rs; const int col = 32 * pair + 16 * e2 + 4 * fq;
            if (col < DI) { v.x = silu_f(v.x); v.y = silu_f(v.y); v.z = silu_f(v.z); v.w = silu_f(v.w); *(f32x4*)(ZSS + (size_t)row * DI + col) = v; }
            else if (col < INMAIN) *(f32x4*)(XBCS + (size_t)row * CONVD + col - DI) = v;
            else { const int h = col - INMAIN; const f32x4 b = *(const f32x4*)(c.in[10] + j * NH + h); v.x = softplus_f(v.x + b.x); v.y = softplus_f(v.y + b.y); v.z = softplus_f(v.z + b.z); v.w = softplus_f(v.w + b.w); *(f32x4*)(DTS + row * 32 + h) = v; } } }
    LDS_BARRIER();
}
__device__ __forceinline__ void prompt_dt(const Ctx& c0, int j) {
    PHASE_CTX(c0);
    const bf16_t* XB = (const bf16_t*)(c.ws + WS_XB); const float* SS = (const float*)(c.ws + WS_SS); const bf16_t* Wt = (const bf16_t*)(c.ws + WS_WSI + j * WSI_STRIDE) + (size_t)INMAIN * D;
    float* DT = (float*)(c.ws + WS_DT); const int fr = c.lane & 15, fq = c.lane >> 4;
    for (int task = c.blk; task < 256; task += c.G) { const int r0 = (task >> 1) * 128, ct = task & 1;
        const int row = r0 + 16 * c.wave + fr, h = 16 * ct + 4 * fq; const float rs = row_rstd(SS, 4, row, 1.f / 1024.f); const f32x4 b = *(const f32x4*)(c.in[10] + j * NH + h);
        const f32x4 a = block_gemm_ks<8, 4, false>(c.wave, c.lane, XB, D, r0, Wt, D, 16 * ct, (LAS float*)c.lds);
        f32x4 v = a * rs + b;
        v.x = softplus_f(v.x); v.y = softplus_f(v.y); v.z = softplus_f(v.z); v.w = softplus_f(v.w); *(f32x4*)(DT + (size_t)row * 32 + h) = v; }
    LDS_BARRIER();
}
__device__ __forceinline__ void sample_mlp_up(const Ctx& c0, int i) {
    PHASE_CTX(c0);
    const bf16_t* XSB = (const bf16_t*)(c.ws + WS_XSB); const float* SSS = (const float*)(c.ws + WS_SSS); const bf16_t* Wt = (const bf16_t*)(c.ws + WS_WUP + i * WUP_STRIDE); bf16_t* HS = (bf16_t*)(c.ws + WS_HS);
    const int fr = c.lane & 15, fq = c.lane >> 4; const int row = 16 * c.wave + fr; const float rs = row_rstd(SSS, 16, row, 1.f / 1024.f);
    for (int tile = c.blk; tile < FF / 16; tile += c.G) {
        f32x4 v = block_gemm_ks<8, 4, true>(c.wave, c.lane, XSB, D, 0, Wt, D, 16 * tile, (LAS float*)c.lds) * rs;
        v.x = fmaxf(v.x, 0.f); v.y = fmaxf(v.y, 0.f); v.z = fmaxf(v.z, 0.f); v.w = fmaxf(v.w, 0.f);
        u32x2 o; o.x = pkbf(v.x * v.x, v.y * v.y); o.y = pkbf(v.z * v.z, v.w * v.w); *(u32x2*)(HS + frag_off(row, phys256(16 * tile + 4 * fq), FF)) = o; }
    LDS_BARRIER();
}
__device__ __forceinline__ void sample_cm_in(const Ctx& c0, int j) {
    PHASE_CTX(c0);
    const bf16_t* XSB = (const bf16_t*)(c.ws + WS_XSB); const float* SSS = (const float*)(c.ws + WS_SSS); const bf16_t* Wt = (const bf16_t*)(c.ws + WS_WCI + j * WCI_STRIDE);
    bf16_t* US = (bf16_t*)(c.ws + WS_US); float* GVS = (float*)(c.ws + WS_GVS); float* SSVS = (float*)(c.ws + WS_SSVS); const float* bias = c.in[16] + (size_t)j * 4096;
    const int fr = c.lane & 15, fq = c.lane >> 4; const int row = 16 * c.wave + fr; const float rs = row_rstd(SSS, 16, row, 1.f / 1024.f);
    for (int tile = c.blk; tile < 4096 / 16; tile += c.G) {
        const int col = 16 * tile + 4 * fq; const f32x4 bv = *(const f32x4*)(bias + col);
        const f32x4 a0 = block_gemm_ks<8, 4, true>(c.wave, c.lane, XSB, D, 0, Wt, D, 16 * tile, (LAS float*)c.lds);
        const f32x4 v = a0 * rs + bv;
        const f32x2 a = pg8::gelu_pk((f32x2){v.x, v.y}), b = pg8::gelu_pk((f32x2){v.z, v.w});
        if (col < CW) { u32x2 o; o.x = pkbf(a.x, a.y); o.y = pkbf(b.x, b.y); *(u32x2*)(US + frag_off(row, phys256(col), CW)) = o; }
        else { *(f32x4*)(GVS + (size_t)row * CW + col - CW) = (f32x4){a.x, a.y, b.x, b.y}; float ss = (a.x * a.x + a.y * a.y) + (b.x * b.x + b.y * b.y);
            ss += __shfl_xor(ss, 16); ss += __shfl_xor(ss, 32); if (fq == 0) SSVS[row * 128 + (tile - 128)] = ss; } }
    LDS_BARRIER();
}

__device__ __forceinline__ void phase_final(const Ctx& c0) {
    PHASE_CTX(c0);
    const int gw = c.blk * NWAVES + c.wave, NGW = c.G * NWAVES; const float* gf = c.in[6];
    for (int m = gw; m < M + MS; m += NGW) {
        if (m < M) { const bf16_t* x = (const bf16_t*)(c.ws + WS_XB) + (size_t)m * D; float* y = c.out + O_Y + (size_t)m * D; const float rs = row_rstd((const float*)(c.ws + WS_SS), 4, m, 1.f / 1024.f);
#pragma unroll
            for (int jx = 0; jx < 4; ++jx) { const int col = 4 * c.lane + 256 * jx; const u32x2 p = *(const u32x2*)(x + col); *(f32x4*)(y + col) = (f32x4){bf_lo(p.x), bf_hi(p.x), bf_lo(p.y), bf_hi(p.y)} * rs * *(const f32x4*)(gf + col); } }
        else { const int r = m - M; const float* x = (const float*)(c.ws + WS_XS) + (size_t)r * D; float* y = c.out + O_YS + (size_t)r * D; const float rs = row_rstd((const float*)(c.ws + WS_SSS), 16, r, 1.f / 1024.f);
#pragma unroll
            for (int jx = 0; jx < 4; ++jx) { const int col = 4 * c.lane + 256 * jx; *(f32x4*)(y + col) = *(const f32x4*)(x + col) * rs * *(const f32x4*)(gf + col); } }
    }
}
#define XB_TMO      128
#define XB_XCNT(j)  (256  + 64 * (j))
#define XB_XSUB(j)  (1280 + 64 * (j))
#define XB_XGEN(j)  (2304 + 64 * (j))
#define XB_TOP      3328
#define XB_TOPGEN   3392
#define XCD_BAR_WORDS 3456
#define XB_SPIN_CAP (1u << 18)

__device__ __forceinline__ unsigned xb_ld(unsigned* p)              { return __hip_atomic_load(p, __ATOMIC_RELAXED, __HIP_MEMORY_SCOPE_AGENT); }
__device__ __forceinline__ unsigned xb_add(unsigned* p, unsigned v) { return __hip_atomic_fetch_add(p, v, __ATOMIC_RELAXED, __HIP_MEMORY_SCOPE_AGENT); }
__device__ __forceinline__ unsigned xb_xcc_id() { return (unsigned)__builtin_amdgcn_s_getreg((3 << 11) | 20) & 0xFu; }
#define XB_SPIN(cond, bar) do { unsigned _sp = 0; while (cond) { __builtin_amdgcn_s_sleep(1); \
    if ((++_sp & 255u) == 0u) { if (xb_ld(&(bar)[XB_TMO])) break; if (_sp > XB_SPIN_CAP) { atomicAdd(&(bar)[XB_TMO], 1u); break; } } } } while (0)

struct XcdBarrier {
    unsigned* bar; unsigned x;
    volatile LAS unsigned* st;
};

__device__ __forceinline__ XcdBarrier xcd_barrier_post(unsigned* bar, volatile LAS unsigned* st) {
    XcdBarrier b; b.bar = bar; b.x = xb_xcc_id(); b.st = st;
    if (threadIdx.x == 0) (void)xb_add(&bar[XB_XCNT(b.x)], 1u);
    return b;
}
__device__ __forceinline__ void xcd_barrier_complete(unsigned* bar, unsigned x, unsigned& nloc, unsigned& nx) {
    const unsigned G = gridDim.x * gridDim.y * gridDim.z;
    unsigned sum, cnt, mine, sp = 0u;
    for (;;) {
        sum = 0u; cnt = 0u; mine = 0u;
#pragma unroll
        for (unsigned j = 0; j < 16; ++j) { const unsigned c = xb_ld(&bar[XB_XCNT(j)]); sum += c; cnt += (c > 0u) ? 1u : 0u; mine = (j == x) ? c : mine; }
        if (sum == G) break;
        __builtin_amdgcn_s_sleep(1);
        if ((++sp & 255u) == 0u) { if (xb_ld(&bar[XB_TMO])) break; if (sp > XB_SPIN_CAP) { atomicAdd(&bar[XB_TMO], 1u); break; } }
    }
    nloc = mine > 0u ? mine : 1u; nx = cnt > 0u ? cnt : 1u;
}

__device__ __forceinline__ void xcd_barrier(const XcdBarrier& b) {
    asm volatile("s_waitcnt vmcnt(0)" ::: "memory");
    __syncthreads();
    if (threadIdx.x == 0) {
        unsigned* bar = b.bar;
        __builtin_amdgcn_s_waitcnt(0);
        unsigned nloc = b.st[0], nx = b.st[1];
        if (nloc == 0u) { xcd_barrier_complete(bar, b.x, nloc, nx); b.st[0] = nloc; b.st[1] = nx; }
        const unsigned old = xb_add(&bar[XB_XSUB(b.x)], 1u);
        const unsigned gen = old / nloc;
        if (old + 1u == (gen + 1u) * nloc) {
            __builtin_amdgcn_fence(__ATOMIC_RELEASE, "agent");
            asm volatile("s_waitcnt vmcnt(0)" ::: "memory");
            const unsigned og = xb_add(&bar[XB_TOP], 1u);
            asm volatile("buffer_inv sc1" ::: "memory");
            const unsigned tg = og / nx;
            if (og + 1u == (tg + 1u) * nx) xb_add(&bar[XB_TOPGEN], 1u);
            else XB_SPIN(xb_ld(&bar[XB_TOPGEN]) == tg, bar);
            xb_add(&bar[XB_XGEN(b.x)], 1u);
            asm volatile("s_waitcnt vmcnt(0)" ::: "memory");
        } else {
            asm volatile("buffer_inv sc1" ::: "memory");
            XB_SPIN(xb_ld(&bar[XB_XGEN(b.x)]) == gen, bar);
            asm volatile("s_waitcnt vmcnt(0)" ::: "memory");
        }
    }
    __syncthreads();
}

#ifndef PH_MASK
#define PH_MASK 0xffffffffu
#endif
#define PHM(k) ((PH_MASK >> (k)) & 1u)
#ifndef STAGGER
#define STAGGER 1
#endif
#ifndef REP_PRO
#define REP_PRO 1
#endif
#ifndef REP_SSDIN
#define REP_SSDIN 1
#endif
#ifndef REP_SCAN1
#define REP_SCAN1 1
#endif
#ifndef REP_SSAMP
#define REP_SSAMP 1
#endif
#ifndef REP_SCAN2
#define REP_SCAN2 1
#endif
#ifndef REP_UP
#define REP_UP 1
#endif
#ifndef REP_CMIN
#define REP_CMIN 1
#endif
#ifndef REP_RESID
#define REP_RESID 1
#endif
#ifndef REP_SRES
#define REP_SRES 1
#endif
#ifndef REP_MIX
#define REP_MIX 1
#endif
#ifndef REP_FIN
#define REP_FIN 1
#endif
#define REPEAT(n) _Pragma("unroll 1") for (int rep_ = 0; rep_ < (n); ++rep_)
struct Args { const float* in[23]; float* out; unsigned char* ws; int ph_lo, ph_hi; };

__global__ void __launch_bounds__(NTHR, 2) hyb_fwd(Args args) {
    extern __shared__ __attribute__((aligned(16))) unsigned char lds_raw[];
    Ctx c;
#pragma unroll
    for (int i = 0; i < 23; ++i) c.in[i] = args.in[i];
    c.out = args.out; c.ws = args.ws;
    c.lds = (LAS unsigned char*)lds_raw;
    c.tid = threadIdx.x; c.lane = c.tid & 63; c.wave = __builtin_amdgcn_readfirstlane(c.tid >> 6); c.blk = blockIdx.x; c.G = gridDim.x;
    volatile LAS unsigned* lctl = (volatile LAS unsigned*)(c.lds + LDSCTL_OFF);
    if (c.tid < 128) lctl[c.tid] = 0u;
    __syncthreads();
    const int lo = args.ph_lo, hi = args.ph_hi;
    XcdBarrier bar; bar.bar = (unsigned*)(c.ws + WS_CTL) + CW_BAR; bar.x = 0; bar.st = lctl;
    if (hi - lo > 1) bar = xcd_barrier_post((unsigned*)(c.ws + WS_CTL) + CW_BAR, lctl);

#pragma unroll 1
    for (int ph_ = lo; ph_ < hi; ++ph_) {
        int ph = ph_; asm volatile("" : "+s"(ph));
        int L = 0, idx = 0, kind;
        if (ph == 0) kind = 0;
        else if (ph == NPHASE - 1) kind = 8;
        else { const int q = ph - 1;
            if (q < 6) { L = 0; idx = q; } else if (q < 11) { L = 1; idx = q - 6; } else if (q < 17) { L = 2; idx = q - 11; } else { L = 3; idx = q - 17; }
            if ((L & 1) == 0) kind = idx == 0 ? 1 : idx == 1 ? 2 : idx == 2 ? 3 : idx == 3 ? 4 : idx == 4 ? 7 : 4;
            else kind = idx == 0 ? 5 : idx == 1 ? 6 : idx == 2 ? 4 : idx == 3 ? 7 : 4; }
        const int j = L >> 1;
        bf16_t* const XB = (bf16_t*)(c.ws + WS_XB); float* const SS = (float*)(c.ws + WS_SS);
        if (kind == 0) { REPEAT(REP_PRO) { phase_prologue(c); if (rep_ + 1 < REP_PRO) __syncthreads(); } }
        else if (kind == 1) {
            REPEAT(REP_SSDIN) {
            const bool late = STAGGER && ((c.blk >> 3) & 1);
            if (!late) { sample_ssd_in(c, j); prompt_dt(c, j); }
            pg8::Gemm g{XB, (const bf16_t*)(c.ws + WS_WSI + j * WSI_STRIDE), M, INMAIN, D}; pg8::StaticOrder S; S.init(M, INMAIN, c.G, c.blk);
            pg8::EpiSsdIn E{(const LAS float*)(c.lds + RSTAB_OFF), (bf16_t*)(c.ws + WS_ZS), (bf16_t*)(c.ws + WS_XBC), c.out + O_CONVP + (size_t)j * NB * 3 * CONVD, c.lds + EPISCR_OFF, c.lds, SS, c.blk};
            pg8::gemm_phase<pg8::EpiSsdIn, pg8::StaticOrder, true, true>(c.lds, g, S, E, c.wave);
            if (late) { sample_ssd_in(c, j); prompt_dt(c, j); } }
        }
        else if (kind == 2) { REPEAT(REP_SCAN1) phase_conv(c, j); }
        else if (kind == 3) { REPEAT(REP_SCAN2) phase_ssd_scan(c, j); }
        else if (kind == 4) {
            const bool ssd = (L & 1) == 0; const bool down = ssd ? idx == 5 : idx == 4;
            const bf16_t* A = (const bf16_t*)(c.ws + (down ? WS_HB : ssd ? WS_YN : WS_ZS));
            const bf16_t* As = (const bf16_t*)(c.ws + (down ? WS_HS : ssd ? WS_YNS : WS_US));
            const bf16_t* Wt = (const bf16_t*)(c.ws + (down ? WS_WDN + L * WDN_STRIDE : ssd ? WS_WSO + j * WSO_STRIDE : WS_WCO + j * WCO_STRIDE));
            const int K = down ? FF : DI;
            const bool first = (L == 0) && !down;
            const float* xsbase = first ? c.in[1] : (const float*)(c.ws + WS_XS);
            REPEAT(REP_SRES - 1) sample_resid(c, As, K, Wt, xsbase, 800 * MiB);
            sample_resid(c, As, K, Wt, xsbase);
            pg8::Gemm g{A, Wt, M, D, K}; pg8::StaticOrder S; S.init(M, D, c.G, c.blk);
            if (ssd && !down) {
                pg8::EpiResidG E{XB, SS, (const LAS float*)(c.lds + RGTAB_OFF), c.lds, (const float*)(c.ws + WS_SSY), c.blk};
                pg8::gemm_phase<pg8::EpiResidG, pg8::StaticOrder, true, true, true>(c.lds, g, S, E, c.wave);
            } else {
                pg8::EpiResid E{XB, SS};
                pg8::gemm_phase<pg8::EpiResid, pg8::StaticOrder, true, true, true>(c.lds, g, S, E, c.wave);
            }
        }
        else if (kind == 5) {
            REPEAT(REP_CMIN) {
            const bool late = STAGGER && ((c.blk >> 3) & 1);
            if (!late) sample_cm_in(c, j);
            pg8::Gemm g{XB, (const bf16_t*)(c.ws + WS_WCI + j * WCI_STRIDE), M, 4096, D}; pg8::StaticOrder S; S.init(M, 4096, c.G, c.blk);
            pg8::EpiCmIn E{(const LAS float*)(c.lds + RSTAB_OFF), c.in[16] + (size_t)j * 4096, (bf16_t*)(c.ws + WS_ZS), (bf16_t*)(c.ws + WS_XBC), (float*)(c.ws + WS_SSV), c.lds + EPISCR_OFF, c.lds, SS, c.blk};
            pg8::gemm_phase<pg8::EpiCmIn, pg8::StaticOrder, true, true>(c.lds, g, S, E, c.wave);
            if (late) sample_cm_in(c, j); }
        }
        else if (kind == 6) { REPEAT(REP_MIX - 1) phase_cm_mix(c, j, (bf16_t*)(c.ws + 700 * MiB), false); phase_cm_mix(c, j, (bf16_t*)(c.ws + WS_ZS), true); }
        else if (kind == 7) {
            REPEAT(REP_UP) {
            const bool late = STAGGER && ((c.blk >> 3) & 1);
            if (!late) sample_mlp_up(c, L);
#ifdef REP_UPX
            REPEAT(REP_UPX) { pg8::Gemm g0{XB, (const bf16_t*)(c.ws + WS_WUP + L * WUP_STRIDE), M, FF, D}; pg8::StaticOrder S0; S0.init(M, FF, c.G, c.blk);
                pg8::EpiMlpUp E0{(const LAS float*)(c.lds + RSTAB_OFF), (bf16_t*)(c.ws + 700 * MiB), c.lds + EPISCR_OFF, c.lds, SS, c.blk, UPX_MODE}; pg8::gemm_phase<pg8::EpiMlpUp, pg8::StaticOrder, true, true>(c.lds, g0, S0, E0, c.wave); }
#endif
#ifdef REP_UPNULL
            REPEAT(REP_UPNULL) { pg8::Gemm g0{XB, (const bf16_t*)(c.ws + WS_WUP + L * WUP_STRIDE), M, FF, D}; pg8::StaticOrder S0; S0.init(M, FF, c.G, c.blk); pg8::EpiNull E0; pg8::gemm_phase<pg8::EpiNull, pg8::StaticOrder, true, true>(c.lds, g0, S0, E0, c.wave); }
#endif
            pg8::Gemm g{XB, (const bf16_t*)(c.ws + WS_WUP + L * WUP_STRIDE), M, FF, D}; pg8::StaticOrder S; S.init(M, FF, c.G, c.blk);
            pg8::EpiMlpUp E{(const LAS float*)(c.lds + RSTAB_OFF), (bf16_t*)(c.ws + WS_HB), c.lds + EPISCR_OFF, c.lds, SS, c.blk};
            pg8::gemm_phase<pg8::EpiMlpUp, pg8::StaticOrder, true, true>(c.lds, g, S, E, c.wave);
            if (late) sample_mlp_up(c, L); }
        }
        else { REPEAT(REP_FIN) phase_final(c); }
        if (ph_ + 1 < hi) { xcd_barrier(bar);
#ifdef REP_BAR
            xcd_barrier(bar);
#endif
        }
    }
}

extern "C" void kernel_launch(void* const* d_in, const int* in_sizes, int n_in, void* d_out, int out_size, void* d_ws, size_t ws_size, hipStream_t stream) {
    static int grid = 0;
    if (grid == 0) {
        if (n_in != 23 || in_sizes[0] != M * D || (size_t)out_size != O_END || ws_size < 900 * MiB) {
            fprintf(stderr, "kernel_launch: unexpected shapes (n_in %d, in0 %d, out %d, ws %zu); nothing launched\n", n_in, n_in > 0 ? in_sizes[0] : -1, out_size, ws_size); grid = -1; return; }
        int dev = 0, cus = 0, per_cu = 0;
        if (hipGetDevice(&dev) != hipSuccess || hipDeviceGetAttribute(&cus, hipDeviceAttributeMultiprocessorCount, dev) != hipSuccess) { fprintf(stderr, "kernel_launch: device query failed\n"); grid = -1; return; }
        if (hipFuncSetAttribute((const void*)hyb_fwd, hipFuncAttributeMaxDynamicSharedMemorySize, LDS_BYTES) != hipSuccess) { fprintf(stderr, "kernel_launch: hipFuncSetAttribute failed\n"); grid = -1; return; }
        if (hipOccupancyMaxActiveBlocksPerMultiprocessor(&per_cu, (const void*)hyb_fwd, NTHR, LDS_BYTES) != hipSuccess || per_cu < 1)
            fprintf(stderr, "kernel_launch: note: occupancy query reports %d workgroups per CU\n", per_cu);
        (void)hipGetLastError();
        grid = cus;
    }
    if (grid < 0) return;
    (void)hipMemsetAsync((char*)d_ws + WS_CTL, 0, CTL_ZERO_BYTES, stream);
    Args a{};
    for (int i = 0; i < 23; ++i) a.in[i] = (const float*)d_in[i];
    a.out = (float*)d_out; a.ws = (unsigned char*)d_ws;
#if MK_N_LAUNCHES == 1
    a.ph_lo = 0; a.ph_hi = NPHASE;
    hipLaunchKernelGGL(hyb_fwd, dim3(grid), dim3(NTHR), LDS_BYTES, stream, a);
#else
    for (int p = 0; p < NPHASE; ++p) { a.ph_lo = p; a.ph_hi = p + 1; hipLaunchKernelGGL(hyb_fwd, dim3(grid), dim3(NTHR), LDS_BYTES, stream, a); }
#endif
}
```

```cpp
#include <hip/hip_runtime.h>
#include <cstdio>
#include <cstdint>
#define MK_N_LAUNCHES 1
namespace pg8 {
#define PG8_LAS __attribute__((address_space(3)))
typedef unsigned short bf16_t;
typedef short bf16x8 __attribute__((ext_vector_type(8)));
typedef float f32x4 __attribute__((ext_vector_type(4)));
typedef unsigned u32x4 __attribute__((ext_vector_type(4)));
constexpr int BM = 256, BK = 64, HALF = 128, HTB = HALF * BK * 2  , STAGE_BYTES = 8 * HTB, NXCD = 8, WGM = 8;

__host__ __device__ __forceinline__ int lds_byte(int r, int c) { const int st = (r >> 4) * 2 + (c >> 5), rr = r & 15, cc = c & 31, ob = rr * 64 + cc * 2; return st * 1024 + (ob ^ (((ob >> 9) & 1) << 5)); }
__host__ __device__ __forceinline__ void stage_rc(int b, int& R, int& C) { const int st = b / 1024, sb = b % 1024, swz = sb ^ (((sb >> 9) & 1) << 5); R = (st >> 1) * 16 + swz / 64; C = (st & 1) * 32 + (swz % 64) / 2; }
__host__ __device__ __forceinline__ int perm32(int rho) { const int n = rho >> 4, i = rho & 15; return 8 * (i >> 2) + 4 * n + (i & 3); }

struct Unit { int pm, pn; };
struct Gemm { const bf16_t* A; const bf16_t* Bt; int M, N, K; };

struct StaticOrder {
    int nM, nN, nwg, G, c;
    __host__ __device__ void init(int M, int N, int G_, int c_) { nM = M / BM; nN = N / BM; nwg = nM * nN; G = G_; c = c_; }
    __host__ __device__ bool next(int i, Unit& u) const {
        const long L = (long)i * G + c; if (L >= nwg) return false;
        int wgid = (int)L; { const int q = nwg / NXCD, r = nwg % NXCD, xcd = wgid % NXCD, off = wgid / NXCD; wgid = (xcd < r ? xcd * (q + 1) : r * (q + 1) + (xcd - r) * q) + off; }
        const int nig = WGM * nN, gid = wgid / nig, fm = gid * WGM, gsz = (nM - fm) < WGM ? (nM - fm) : WGM;
        u.pm = fm + ((wgid % nig) % gsz); u.pn = (wgid % nig) / gsz; return true;
    }
    __device__ __forceinline__ void a_ready(const Unit&) const {}
    __device__ __forceinline__ void done(const Unit&) const {}
};
__device__ __forceinline__ unsigned cvt_pk_bf16(float lo, float hi) { unsigned r; asm volatile("v_cvt_pk_bf16_f32 %0, %1, %2" : "=v"(r) : "v"(lo), "v"(hi)); return r; }
typedef float f32x2 __attribute__((ext_vector_type(2)));
__device__ __forceinline__ f32x2 gelu_pk(f32x2 v) {
    const f32x2 av = __builtin_elementwise_abs(v), d = av * 0.2316418882f + 1.0f;
    f32x2 t; t.x = __builtin_amdgcn_rcpf(d.x); t.y = __builtin_amdgcn_rcpf(d.y);
    f32x2 q = t * 0.5307027145f + (-0.7265760135f); q = q * t + 0.7107068705f; q = q * t + (-0.142248368f); q = q * t + 0.127414796f; q = q * t;
    const f32x2 s = (v * v) * (-0.72134752044f);
    f32x2 e; e.x = __builtin_amdgcn_exp2f(s.x); e.y = __builtin_amdgcn_exp2f(s.y);
    const f32x2 w = av * (q * e);
    f32x2 o; o.x = fmaxf(v.x, 0.f) - w.x; o.y = fmaxf(v.y, 0.f) - w.y; return o;
}
template <class Epi, class Sched, bool ALIGN_EPI = false, bool SP2 = false, bool TILED_A = false>
__device__ __forceinline__ void gemm_phase(PG8_LAS unsigned char* lds, const Gemm g, const Sched& S, const Epi& E, const int wave_id) {
    unsigned ones_l = ~0u; asm volatile("" : "+s"(ones_l)); const int tid_l = wave_id * 64 + (int)__builtin_amdgcn_mbcnt_hi(ones_l, __builtin_amdgcn_mbcnt_lo(ones_l, 0u));
    const int tid = tid_l, wid = __builtin_amdgcn_readfirstlane(tid >> 6), lane = tid & 63, wr = wid >> 2, wc = wid & 3, fr = lane & 15, fq = lane >> 4;
    const int K = g.K, nt = K / BK;
    unsigned voffA[2], voffB[2];
#pragma unroll
    for (int i = 0; i < 2; ++i) { int R, C; stage_rc(tid * 16 + i * 8192, R, C); const int Rb = Epi::PERM ? ((R & ~31) + perm32(R & 31)) : R;
        voffA[i] = (unsigned)(R * (TILED_A ? BK : K) + C) * 2u; voffB[i] = (unsigned)(Rb * K + C) * 2u; }
    const size_t kstep = (size_t)(BK * 2);
    const size_t hstep = (size_t)HALF * K * 2;
    const size_t tstep = 2 * hstep;
    const size_t kstepA = TILED_A ? (size_t)(2 * HALF * BK * 2) : kstep, hstepA = TILED_A ? (size_t)(HALF * BK * 2) : hstep, tstepA = TILED_A ? (size_t)nt * (2 * HALF * BK * 2) : tstep;
    const unsigned ldsw = (unsigned)wid * 1024u;
    const int aoff = lds_byte(wr * 64 + fr, fq * 8), boff = lds_byte(wc * 32 + fr, fq * 8);
#define PG8_SA(b, h) (((b) * 2 + (h)) * HTB)
#define PG8_SB(b, h) ((4 + (b) * 2 + (h)) * HTB)
#define PG8_STAGE(bufoff, gbase, voff) do { _Pragma("unroll") for (int _i = 0; _i < 2; ++_i) \
        __builtin_amdgcn_global_load_lds((const unsigned*)((const char*)(gbase) + (voff)[_i]), (PG8_LAS unsigned*)(lds + (bufoff) + ldsw + _i * 8192), 16, 0, 0); } while (0)
#define PG8_LDA(dst, b, h) do { _Pragma("unroll") for (int m = 0; m < 4; ++m) _Pragma("unroll") for (int k = 0; k < 2; ++k) dst[m][k] = *(const PG8_LAS bf16x8*)(lds + PG8_SA(b, h) + aoff + m * 2048 + k * 1024); } while (0)
#define PG8_LDB(dst, b, h) do { _Pragma("unroll") for (int n = 0; n < 2; ++n) _Pragma("unroll") for (int k = 0; k < 2; ++k) dst[n][k] = *(const PG8_LAS bf16x8*)(lds + PG8_SB(b, h) + boff + n * 2048 + k * 1024); } while (0)
#define PG8_MMA(ai, bj, At, Bt) do { __builtin_amdgcn_s_setprio(1); _Pragma("unroll") for (int m = 0; m < 4; ++m) _Pragma("unroll") for (int n = 0; n < 2; ++n) _Pragma("unroll") for (int k = 0; k < 2; ++k) \
        acc[ai][bj][m][n] = __builtin_amdgcn_mfma_f32_16x16x32_bf16(Bt[n][k], At[m][k], acc[ai][bj][m][n], 0, 0, 0); __builtin_amdgcn_s_setprio(0); } while (0)
#define PG8_WAIT_V(n) asm volatile("s_waitcnt vmcnt(" #n ")" ::: "memory")
#define PG8_WAIT_L(n) asm volatile("s_waitcnt lgkmcnt(" #n ")" ::: "memory")
#define PG8_BAR __builtin_amdgcn_s_barrier()
#define PG8_SCHED __builtin_amdgcn_sched_barrier(0)
    Unit cur, nxt; int ui = 0;
    if (!S.next(0, cur)) return;
    f32x4 acc[2][2][4][2];
#pragma unroll
    for (int a = 0; a < 2; ++a)
#pragma unroll
        for (int b = 0; b < 2; ++b)
#pragma unroll
            for (int m = 0; m < 4; ++m)
#pragma unroll
                for (int n = 0; n < 2; ++n) acc[a][b][m][n] = (f32x4){0.f, 0.f, 0.f, 0.f};
    bf16x8 At[4][2], B0[2][2], B1[2][2];
    const char* cA = (const char*)g.A + (size_t)cur.pm * tstepA; const char* cB = (const char*)g.Bt + (size_t)cur.pn * tstep;
    S.a_ready(cur);
    if constexpr (SP2) {
        PG8_STAGE(PG8_SB(0, 0), cB, voffB); PG8_STAGE(PG8_SB(0, 1), cB + hstep, voffB); PG8_STAGE(PG8_SA(0, 0), cA, voffA); PG8_STAGE(PG8_SA(0, 1), cA + hstepA, voffA);
        E.pre(tid);
        if (wr == 1) PG8_BAR;
        PG8_WAIT_V(2); PG8_BAR;
        PG8_STAGE(PG8_SB(1, 0), cB + kstep, voffB); PG8_STAGE(PG8_SA(1, 0), cA + kstepA, voffA); PG8_STAGE(PG8_SB(1, 1), cB + hstep + kstep, voffB);
        PG8_WAIT_V(6); PG8_BAR;
    } else {
        PG8_STAGE(PG8_SB(0, 0), cB, voffB); PG8_STAGE(PG8_SA(0, 0), cA, voffA); PG8_STAGE(PG8_SB(0, 1), cB + hstep, voffB); PG8_STAGE(PG8_SA(0, 1), cA + hstepA, voffA);
        E.pre(tid);
        if (wr == 1) PG8_BAR;
        PG8_WAIT_V(4); PG8_BAR;
        PG8_STAGE(PG8_SB(1, 0), cB + kstep, voffB); PG8_STAGE(PG8_SA(1, 0), cA + kstepA, voffA); PG8_STAGE(PG8_SB(1, 1), cB + hstep + kstep, voffB);
        PG8_WAIT_V(6); PG8_BAR;
    }
    for (;;) {
        const bool has_next = S.next(ui + 1, nxt);
        const char* nA = has_next ? (const char*)g.A + (size_t)nxt.pm * tstepA : cA; const char* nB = has_next ? (const char*)g.Bt + (size_t)nxt.pn * tstep : cB;
        for (int t = 0; t < nt; t += 2) {
if constexpr (Epi::KHOOK) { asm volatile("" : "+v"(voffA[0]), "+v"(voffA[1]), "+v"(voffB[0]), "+v"(voffB[1])); }
            if constexpr (Epi::KHOOK) E.khook(acc, t, wr, fr);
            const bool last = (t == nt - 2);
            const char* a1 = cA + (size_t)(t + 1) * kstepA;
            const char* a2 = last ? nA : cA + (size_t)(t + 2) * kstepA; const char* b2 = last ? nB : cB + (size_t)(t + 2) * kstep;
            const char* a3 = a2 + kstepA; const char* b3 = b2 + kstep;
            if (last && has_next) S.a_ready(nxt);
            if constexpr (SP2) {
            PG8_LDB(B0, 0, 0); PG8_LDB(B1, 0, 1); PG8_SCHED; PG8_LDA(At, 0, 0); PG8_STAGE(PG8_SA(1, 1), a1 + hstepA, voffA);
            PG8_WAIT_V(8); PG8_WAIT_L(0); PG8_BAR; PG8_MMA(0, 0, At, B0); PG8_MMA(0, 1, At, B1); PG8_BAR; PG8_SCHED;
            PG8_LDA(At, 0, 1); PG8_STAGE(PG8_SB(0, 0), b2, voffB); PG8_STAGE(PG8_SB(0, 1), b2 + hstep, voffB); PG8_STAGE(PG8_SA(0, 0), a2, voffA);
            PG8_WAIT_V(8); PG8_WAIT_L(0); PG8_BAR; PG8_MMA(1, 0, At, B0); PG8_MMA(1, 1, At, B1); PG8_BAR; PG8_SCHED;
            PG8_LDB(B0, 1, 0); PG8_LDB(B1, 1, 1); PG8_SCHED; PG8_LDA(At, 1, 0); PG8_STAGE(PG8_SA(0, 1), a2 + hstepA, voffA);
            PG8_WAIT_V(8); PG8_WAIT_L(0); PG8_BAR; PG8_MMA(0, 0, At, B0); PG8_MMA(0, 1, At, B1); PG8_BAR; PG8_SCHED;
            PG8_LDA(At, 1, 1); PG8_STAGE(PG8_SB(1, 0), b3, voffB); PG8_STAGE(PG8_SB(1, 1), b3 + hstep, voffB); PG8_STAGE(PG8_SA(1, 0), a3, voffA);
            PG8_WAIT_V(8); PG8_WAIT_L(0); PG8_BAR; PG8_MMA(1, 0, At, B0); PG8_MMA(1, 1, At, B1); PG8_BAR; PG8_SCHED;
            } else {
            PG8_LDB(B0, 0, 0); PG8_SCHED; PG8_LDA(At, 0, 0); PG8_STAGE(PG8_SA(1, 1), a1 + hstepA, voffA);
            PG8_WAIT_L(8); PG8_BAR; PG8_WAIT_L(0); PG8_MMA(0, 0, At, B0); PG8_BAR; PG8_SCHED;
            PG8_LDB(B1, 0, 1); PG8_STAGE(PG8_SB(0, 0), b2, voffB);
            PG8_BAR; PG8_WAIT_L(0); PG8_MMA(0, 1, At, B1); PG8_BAR;
            PG8_LDA(At, 0, 1); PG8_STAGE(PG8_SA(0, 0), a2, voffA);
            PG8_BAR; PG8_WAIT_L(0); PG8_MMA(1, 0, At, B0); PG8_BAR; PG8_SCHED;
            PG8_STAGE(PG8_SB(0, 1), b2 + hstep, voffB);
            PG8_WAIT_V(6); PG8_BAR; PG8_MMA(1, 1, At, B1); PG8_BAR;
            PG8_LDB(B0, 1, 0); PG8_SCHED; PG8_LDA(At, 1, 0); PG8_STAGE(PG8_SA(0, 1), a2 + hstepA, voffA);
            PG8_WAIT_L(8); PG8_BAR; PG8_WAIT_L(0); PG8_MMA(0, 0, At, B0); PG8_BAR; PG8_SCHED;
            PG8_LDB(B1, 1, 1); PG8_STAGE(PG8_SB(1, 0), b3, voffB);
            PG8_BAR; PG8_WAIT_L(0); PG8_MMA(0, 1, At, B1); PG8_BAR;
            PG8_LDA(At, 1, 1); PG8_STAGE(PG8_SA(1, 0), a3, voffA);
            PG8_BAR; PG8_WAIT_L(0); PG8_MMA(1, 0, At, B0); PG8_BAR; PG8_SCHED;
            PG8_STAGE(PG8_SB(1, 1), b3 + hstep, voffB);
            PG8_WAIT_V(6); PG8_BAR; PG8_MMA(1, 1, At, B1); PG8_BAR;
            }
        }
        if constexpr (ALIGN_EPI) { if (wr == 0) PG8_BAR; }
        if constexpr (!Epi::AFTER_DRAIN) { E(acc, cur, wr, wc, fr, fq); S.done(cur); }
        if (!has_next) break;
#pragma unroll
        for (int a = 0; a < 2; ++a)
#pragma unroll
            for (int b = 0; b < 2; ++b)
#pragma unroll
                for (int m = 0; m < 4; ++m)
#pragma unroll
                    for (int n = 0; n < 2; ++n) acc[a][b][m][n] = (f32x4){0.f, 0.f, 0.f, 0.f};
        cur = nxt; cA = nA; cB = nB; ++ui;
        if constexpr (ALIGN_EPI) { if (wr == 1) PG8_BAR; }
    }
    PG8_WAIT_V(0);
    if constexpr (!ALIGN_EPI) { if (wr == 0) PG8_BAR; }
    PG8_BAR;
    if constexpr (Epi::AFTER_DRAIN) { E.fused(acc, cur, wr, wc, fr, fq, lds, wid, lane); S.done(cur); }
#undef PG8_SA
#undef PG8_SB
#undef PG8_STAGE
#undef PG8_LDA
#undef PG8_LDB
#undef PG8_MMA
#undef PG8_WAIT_V
#undef PG8_WAIT_L
#undef PG8_BAR
#undef PG8_SCHED
}
}
#define LAS __attribute__((address_space(3)))
typedef unsigned short bf16_t;
typedef short bf16x8 __attribute__((ext_vector_type(8)));
typedef float f32x4 __attribute__((ext_vector_type(4)));
typedef float f32x2 __attribute__((ext_vector_type(2)));
typedef unsigned u32x4 __attribute__((ext_vector_type(4)));
typedef unsigned u32x2 __attribute__((ext_vector_type(2)));
typedef __bf16 bf16x2_t __attribute__((ext_vector_type(2)));

#ifndef MK_N_LAUNCHES
#define MK_N_LAUNCHES 1
#endif

constexpr int NWAVES = 8, NTHR = 512;
constexpr int M = 16384, MS = 128, SEQ = 2048, NB = 8, D = 1024;
constexpr int DI = 2048, NH = 32, HD = 64, NG = 8, HPG = 4, NST = 128, CONVD = 4096, INDIM = 6176, INMAIN = 6144;
constexpr int CW = 2048, FF = 4096, NCHUNK = 16, CH = 128;
constexpr size_t XC_BOFF = (size_t)NB * NH * SEQ * HD, XC_COFF = XC_BOFF + (size_t)NB * NG * SEQ * NST;
constexpr float EPS = 1e-5f;
constexpr int NPHASE = 24;

constexpr size_t O_Y = 0, O_YS = 16777216, O_SSMP = 16908288, O_CONVP = 21102592, O_SSMS = 21299200, O_CONVS = 88408064, O_CMV = 91553792, O_END = 92078080;

constexpr size_t MiB = 1u << 20;
constexpr size_t WS_CTL = 0, CTL_ZERO_BYTES = 1 * MiB;
constexpr size_t WS_WSI = 2 * MiB, WSI_STRIDE = 13 * MiB;
constexpr size_t WS_WSO = 28 * MiB, WSO_STRIDE = 4 * MiB;
constexpr size_t WS_WCI = 36 * MiB, WCI_STRIDE = 8 * MiB;
constexpr size_t WS_WCO = 52 * MiB, WCO_STRIDE = 4 * MiB;
constexpr size_t WS_WUP = 60 * MiB, WUP_STRIDE = 8 * MiB;
constexpr size_t WS_WDN = 92 * MiB, WDN_STRIDE = 8 * MiB;
constexpr size_t WS_X = 124 * MiB;
constexpr size_t WS_XB = 188 * MiB;
constexpr size_t WS_SS = 220 * MiB;
constexpr size_t WS_SSV = 221 * MiB;
constexpr size_t WS_DT = 223 * MiB;
constexpr size_t WS_SSY = 236 * MiB;
constexpr size_t WS_XS = 225 * MiB;
constexpr size_t WS_XSB = WS_XS + 512 * 1024;
constexpr size_t WS_SSS = WS_XSB + 256 * 1024;
constexpr size_t WS_SSVS = WS_SSS + 32 * 1024;
constexpr size_t WS_DTS = WS_SSVS + 64 * 1024;
constexpr size_t WS_ZSS = 226 * MiB;
constexpr size_t WS_XBCS = 227 * MiB;
constexpr size_t WS_YNS = 229 * MiB;
constexpr size_t WS_HS = 230 * MiB;
constexpr size_t WS_US = 231 * MiB;
constexpr size_t WS_GVS = 232 * MiB;
constexpr size_t WS_ZS = 240 * MiB;
constexpr size_t WS_XBC = 304 * MiB;
constexpr size_t WS_HPREV = 432 * MiB;
constexpr size_t WS_YN = 496 * MiB;
constexpr size_t WS_HB = 560 * MiB;
constexpr size_t WS_XC = 688 * MiB;
constexpr size_t WS_END = 816 * MiB;
constexpr int CW_BAR = 4096;

constexpr int LDS_BYTES = 160 * 1024;
constexpr int LDSCTL_OFF = LDS_BYTES - 512;
constexpr int TP = 272;

#define LDS_WAIT() asm volatile("s_waitcnt lgkmcnt(0)" ::: "memory")
#define VM_WAIT() asm volatile("s_waitcnt vmcnt(0)" ::: "memory")
__device__ __forceinline__ unsigned pkbf(float lo, float hi) { f32x2 v = {lo, hi}; bf16x2_t b = __builtin_convertvector(v, bf16x2_t); return __builtin_bit_cast(unsigned, b); }
__device__ __forceinline__ float bf_lo(unsigned w) { return __uint_as_float(w << 16); }
__device__ __forceinline__ float bf_hi(unsigned w) { return __uint_as_float(w & 0xffff0000u); }
__device__ __forceinline__ float bf1(bf16_t h) { return __uint_as_float(((unsigned)h) << 16); }
__device__ __forceinline__ float exp_f(float x) { return __builtin_amdgcn_exp2f(x * 1.4426950408889634f); }
__device__ __forceinline__ float silu_f(float v) { return v * __builtin_amdgcn_rcpf(1.f + __builtin_amdgcn_exp2f(-1.4426950408889634f * v)); }
__device__ __forceinline__ float softplus_f(float x) { return x > 20.f ? x : log1pf(expf(x)); }
__device__ __forceinline__ float wave_sum(float v) {
#pragma unroll
    for (int o = 1; o < 64; o <<= 1) v += __shfl_xor(v, o);
    return v;
}
#define LDS_BARRIER() do { asm volatile("s_waitcnt lgkmcnt(0)" ::: "memory"); __builtin_amdgcn_s_barrier(); asm volatile("" ::: "memory"); } while (0)
__device__ __forceinline__ int lane_id_fresh() { unsigned ones = ~0u; asm volatile("" : "+s"(ones)); return (int)__builtin_amdgcn_mbcnt_hi(ones, __builtin_amdgcn_mbcnt_lo(ones, 0u)); }
__host__ __device__ __forceinline__ int phys256(int c) { return (c & ~255) | (((c >> 5) & 3) << 6) | (((c >> 7) & 1) << 5) | (c & 31); }
__host__ __device__ __forceinline__ int log256(int c) { return (c & ~255) | (((c >> 5) & 1) << 7) | (((c >> 6) & 3) << 5) | (c & 31); }
constexpr int EPISCR_OFF = 132096, EPISCR_PITCH = 144, EPISCR_WAVE = 16 * 144;
__host__ __device__ __forceinline__ size_t frag_off(int row, int k, int K) { return ((size_t)((row >> 4) * (K >> 5) + (k >> 5)) * 64 + (((k >> 3) & 3) * 16 + (row & 15))) * 8 + (k & 7); }
__device__ __forceinline__ float dot4(f32x4 a) { return (a.x * a.x + a.y * a.y) + (a.z * a.z + a.w * a.w); }
__device__ __forceinline__ float row_rstd(const float* ss, int ns4, int row, float inv_n) {
    const f32x4* p = (const f32x4*)(ss + (size_t)row * ns4 * 4); float s = 0.f;
    for (int i = 0; i < ns4; ++i) { const f32x4 v = p[i]; s += (v.x + v.y) + (v.z + v.w); }
    return rsqrtf(s * inv_n + EPS);
}

constexpr int RSTAB_OFF = 131072;
__device__ __forceinline__ int panel_of(int c) { return 8 * (c & 7) + ((c >> 3) & 7); }
__device__ __forceinline__ void fill_rstd_table(LAS unsigned char* lds, const float* SS, int blk, int tid) {
    if (tid < 256) ((LAS float*)(lds + RSTAB_OFF))[tid] = row_rstd(SS, 4, panel_of(blk) * 256 + tid, 1.f / 1024.f);
    asm volatile("s_waitcnt lgkmcnt(0)" ::: "memory");
}

constexpr int RGTAB_OFF = RSTAB_OFF + 1024;
constexpr int RG7_OFF = RGTAB_OFF + 16384;
__device__ __forceinline__ void fill_group_table(LAS unsigned char* lds, const float* SSY, int blk, int tid) {
    if (tid < 256) { const f32x4* p = (const f32x4*)(SSY + ((size_t)panel_of(blk) * 256 + tid) * 32); float s[8];
#pragma unroll
        for (int g = 0; g < 8; ++g) { const f32x4 v = p[g]; s[g] = rsqrtf(((v.x + v.y) + (v.z + v.w)) * (1.f / 256.f) + EPS); }
        LAS float* o = (LAS float*)(lds + RGTAB_OFF) + tid;
#pragma unroll
        for (int i = 0; i < 16; ++i) o[i * 256] = ((i & 1) == 0 && i > 0) ? s[(i >> 1) - 1] / s[i >> 1] : 1.f;
        ((LAS float*)(lds + RG7_OFF))[tid] = s[7]; }
    asm volatile("s_waitcnt lgkmcnt(0)" ::: "memory");
}

#ifndef WT_STORES
#define WT_STORES 1
#endif
#ifndef WT_AUX
#define WT_AUX 16
#endif
__device__ __forceinline__ void st_wt(bf16_t* base, unsigned bytes, size_t off_elems, u32x4 v) {
#if WT_STORES
    __builtin_amdgcn_raw_buffer_store_b128(v, __builtin_amdgcn_make_buffer_rsrc(base, 0, bytes, 0x00020000), (int)(off_elems * 2), 0, WT_AUX);
#else
    *(u32x4*)(base + off_elems) = v;
#endif
}

namespace pg8 {
struct EpiResid {
    static constexpr bool PERM = true, AFTER_DRAIN = false, KHOOK = false;
    __device__ __forceinline__ void pre(int tid) const {  }
    bf16_t* XB; float* SS;
    __device__ __forceinline__ void operator()(const f32x4 (&acc)[2][2][4][2], const Unit& u, int wr, int wc, int fr, int fq) const {
        const int row0 = u.pm * BM + wr * 64 + fr, col0 = u.pn * BM + wc * 32 + 8 * fq;
        u32x4 pre2[2][4][2];
#pragma unroll
        for (int ai = 0; ai < 2; ++ai)
#pragma unroll
            for (int m = 0; m < 4; ++m)
#pragma unroll
                for (int bj = 0; bj < 2; ++bj) pre2[ai][m][bj] = *(const u32x4*)(XB + (size_t)(row0 + ai * HALF + m * 16) * 1024 + col0 + bj * HALF);
#pragma unroll
        for (int ai = 0; ai < 2; ++ai) {
#pragma unroll
            for (int m = 0; m < 4; ++m) { const int row = row0 + ai * HALF + m * 16; float ss = 0.f;
#pragma unroll
                for (int bj = 0; bj < 2; ++bj) { const size_t off = (size_t)row * 1024 + col0 + bj * HALF; const u32x4 p = pre2[ai][m][bj];
                    const f32x4 v0 = acc[ai][bj][m][0] + (f32x4){::bf_lo(p.x), ::bf_hi(p.x), ::bf_lo(p.y), ::bf_hi(p.y)}, v1 = acc[ai][bj][m][1] + (f32x4){::bf_lo(p.z), ::bf_hi(p.z), ::bf_lo(p.w), ::bf_hi(p.w)};
                    u32x4 w; w.x = ::pkbf(v0[0], v0[1]); w.y = ::pkbf(v0[2], v0[3]); w.z = ::pkbf(v1[0], v1[1]); w.w = ::pkbf(v1[2], v1[3]);
                    ::st_wt(XB, 16384u * 1024u * 2u, off, w); ss += ::dot4(v0) + ::dot4(v1); }
                ss += __shfl_xor(ss, 16); ss += __shfl_xor(ss, 32);
                if (fq == 0) SS[(size_t)row * 16 + u.pn * 4 + wc] = ss; }
            asm volatile("" ::: "memory");
        }
    }
};
struct EpiResidG {
    static constexpr bool PERM = true, AFTER_DRAIN = false, KHOOK = true;
    bf16_t* XB; float* SS; const LAS float* RG; LAS unsigned char* ldsb; const float* SSY; int blk;
    __device__ __forceinline__ void pre(int tid) const { fill_group_table(ldsb, SSY, blk, tid); }
    __device__ __forceinline__ void khook(f32x4 (&acc)[2][2][4][2], int t, int wr, int fr) const {
        const LAS float* rg = RG + (t >> 1) * 256 + wr * 64 + fr;
#pragma unroll
        for (int ai = 0; ai < 2; ++ai)
#pragma unroll
            for (int m = 0; m < 4; ++m) { const float rt = rg[ai * HALF + m * 16];
#pragma unroll
                for (int bj = 0; bj < 2; ++bj) { acc[ai][bj][m][0] = acc[ai][bj][m][0] * rt; acc[ai][bj][m][1] = acc[ai][bj][m][1] * rt; } }
    }
    __device__ __forceinline__ void operator()(const f32x4 (&acc)[2][2][4][2], const Unit& u, int wr, int wc, int fr, int fq) const {
        const int row0 = u.pm * BM + wr * 64 + fr, col0 = u.pn * BM + wc * 32 + 8 * fq;
        u32x4 pre2[2][4][2];
#pragma unroll
        for (int ai = 0; ai < 2; ++ai)
#pragma unroll
            for (int m = 0; m < 4; ++m)
#pragma unroll
                for (int bj = 0; bj < 2; ++bj) pre2[ai][m][bj] = *(const u32x4*)(XB + (size_t)(row0 + ai * HALF + m * 16) * 1024 + col0 + bj * HALF);
#pragma unroll
        for (int ai = 0; ai < 2; ++ai) {
#pragma unroll
            for (int m = 0; m < 4; ++m) { const int row = row0 + ai * HALF + m * 16; float ss = 0.f; const float s7 = RG[4096 + wr * 64 + fr + ai * HALF + m * 16];
#pragma unroll
                for (int bj = 0; bj < 2; ++bj) { const size_t off = (size_t)row * 1024 + col0 + bj * HALF; const u32x4 p = pre2[ai][m][bj];
                    const f32x4 v0 = acc[ai][bj][m][0] * s7 + (f32x4){::bf_lo(p.x), ::bf_hi(p.x), ::bf_lo(p.y), ::bf_hi(p.y)}, v1 = acc[ai][bj][m][1] * s7 + (f32x4){::bf_lo(p.z), ::bf_hi(p.z), ::bf_lo(p.w), ::bf_hi(p.w)};
                    u32x4 w; w.x = ::pkbf(v0[0], v0[1]); w.y = ::pkbf(v0[2], v0[3]); w.z = ::pkbf(v1[0], v1[1]); w.w = ::pkbf(v1[2], v1[3]);
                    ::st_wt(XB, 16384u * 1024u * 2u, off, w); ss += ::dot4(v0) + ::dot4(v1); }
                ss += __shfl_xor(ss, 16); ss += __shfl_xor(ss, 32);
                if (fq == 0) SS[(size_t)row * 16 + u.pn * 4 + wc] = ss; }
            asm volatile("" ::: "memory");
        }
    }
};
struct EpiSsdIn {
    static constexpr bool PERM = true, AFTER_DRAIN = false, KHOOK = false;
    const LAS float* RS; bf16_t* ZS; bf16_t* XBC; float* convst; LAS unsigned char* scr; LAS unsigned char* ldsb; const float* SSp; int blk;
    __device__ __forceinline__ void pre(int tid) const { fill_rstd_table(ldsb, SSp, blk, tid); }
    __device__ __forceinline__ void operator()(const f32x4 (&acc)[2][2][4][2], const Unit& u, int wr, int wc, int fr, int fq) const {
        const int row0 = u.pm * BM + wr * 64 + fr, col0 = u.pn * BM + wc * 32 + 8 * fq; const bool isz = u.pn < 8;
        LAS unsigned char* sw = scr + (wr * 4 + wc) * EPISCR_WAVE; const int lane = fq * 16 + fr, rrow = lane >> 3, rchunk = lane & 7;
        bf16_t* dst = isz ? ZS : XBC; const int ldd = isz ? 2048 : 4096; const unsigned nbytes = isz ? 16384u * 2048u * 2u : 16384u * 4096u * 2u;
        const size_t gbase = (size_t)(u.pm * BM + wr * 64 + rrow) * ldd + (isz ? u.pn * BM : u.pn * BM - 2048) + wc * 64 + rchunk * 8;
#pragma unroll
        for (int ai = 0; ai < 2; ++ai)
#pragma unroll
            for (int m = 0; m < 4; ++m) { const int row = row0 + ai * HALF + m * 16; const float rs = RS[wr * 64 + fr + ai * HALF + m * 16];
#pragma unroll
                for (int bj = 0; bj < 2; ++bj) { const int c = col0 + bj * HALF; f32x4 v0 = acc[ai][bj][m][0] * rs, v1 = acc[ai][bj][m][1] * rs; u32x4 w;
                    if (isz) { w.x = ::pkbf(::silu_f(v0[0]), ::silu_f(v0[1])); w.y = ::pkbf(::silu_f(v0[2]), ::silu_f(v0[3])); w.z = ::pkbf(::silu_f(v1[0]), ::silu_f(v1[1])); w.w = ::pkbf(::silu_f(v1[2]), ::silu_f(v1[3])); }
                    else { w.x = ::pkbf(v0[0], v0[1]); w.y = ::pkbf(v0[2], v0[3]); w.z = ::pkbf(v1[0], v1[1]); w.w = ::pkbf(v1[2], v1[3]);
                        const int t = row & 2047;
                        if (t >= 2045) { float* o = convst + ((size_t)(row >> 11) * 3 + (t - 2045)) * 4096 + c - 2048; *(f32x4*)o = v0; *(f32x4*)(o + 4) = v1; } }
                    *(LAS u32x4*)(sw + fr * EPISCR_PITCH + bj * 64 + fq * 16) = w; }
#pragma unroll
                for (int hh = 0; hh < 2; ++hh) { const u32x4 w = *(const LAS u32x4*)(sw + (hh * 8 + rrow) * EPISCR_PITCH + rchunk * 16);
                    ::st_wt(dst, nbytes, gbase + (size_t)(ai * HALF + m * 16 + hh * 8) * ldd, w); } }
    }
};
struct EpiMlpUp {
    static constexpr bool PERM = true, AFTER_DRAIN = false, KHOOK = false;
    const LAS float* RS; bf16_t* HB; LAS unsigned char* scr; LAS unsigned char* ldsb; const float* SSp; int blk; int mode = 0;
    __device__ __forceinline__ void pre(int tid) const { fill_rstd_table(ldsb, SSp, blk, tid); }
    __device__ __forceinline__ void operator()(const f32x4 (&acc)[2][2][4][2], const Unit& u, int wr, int wc, int fr, int fq) const {
        LAS unsigned char* sw = scr + (wr * 4 + wc) * EPISCR_WAVE; const int lane = fq * 16 + fr;
        const int rrow = lane >> 3, rchunk = lane & 7;
        const size_t gbase = ((size_t)(u.pm * 64 + u.pn * 4 + wc) * BM + wr * 64 + rrow) * 64 + rchunk * 8;
#pragma unroll
        for (int ai = 0; ai < 2; ++ai)
#pragma unroll
            for (int m = 0; m < 4; ++m) { const float rs = RS[wr * 64 + fr + ai * HALF + m * 16];
#pragma unroll
                for (int bj = 0; bj < 2; ++bj) { f32x4 v0 = acc[ai][bj][m][0] * rs, v1 = acc[ai][bj][m][1] * rs;
#pragma unroll
                    for (int e = 0; e < 4; ++e) { const float a = fmaxf(v0[e], 0.f), b = fmaxf(v1[e], 0.f); v0[e] = a * a; v1[e] = b * b; }
                    u32x4 w; w.x = ::pkbf(v0[0], v0[1]); w.y = ::pkbf(v0[2], v0[3]); w.z = ::pkbf(v1[0], v1[1]); w.w = ::pkbf(v1[2], v1[3]);
                    *(LAS u32x4*)(sw + fr * EPISCR_PITCH + bj * 64 + fq * 16) = w; }
#pragma unroll
                for (int hh = 0; hh < 2; ++hh) { const u32x4 w = *(const LAS u32x4*)(sw + (hh * 8 + rrow) * EPISCR_PITCH + rchunk * 16);
                    if (mode == 0) ::st_wt(HB, 16384u * 4096u * 2u, gbase + (size_t)(ai * HALF + m * 16 + hh * 8) * 64, w); else if (mode == 2) *(u32x4*)(HB + gbase + (size_t)(ai * HALF + m * 16 + hh * 8) * 64) = w; else asm volatile("" :: "v"(w.x), "v"(w.y), "v"(w.z), "v"(w.w)); } }
    }
};
struct EpiCmIn {
    static constexpr bool PERM = true, AFTER_DRAIN = false, KHOOK = false;
    const LAS float* RS; const float* bias; bf16_t* U; bf16_t* GV; float* SSV; LAS unsigned char* scr; LAS unsigned char* ldsb; const float* SSp; int blk;
    __device__ __forceinline__ void pre(int tid) const { fill_rstd_table(ldsb, SSp, blk, tid); }
    __device__ __forceinline__ void operator()(const f32x4 (&acc)[2][2][4][2], const Unit& u, int wr, int wc, int fr, int fq) const {
        const int row0 = u.pm * BM + wr * 64 + fr, col0 = u.pn * BM + wc * 32 + 8 * fq; const bool isu = u.pn < 8;
        LAS unsigned char* sw = scr + (wr * 4 + wc) * EPISCR_WAVE; const int lane = fq * 16 + fr, rrow = lane >> 3, rchunk = lane & 7;
        bf16_t* dst = isu ? U : GV;
        const size_t gbase = isu ? ((size_t)(u.pm * 32 + u.pn * 4 + wc) * BM + wr * 64 + rrow) * 64 + rchunk * 8
                                 : ((size_t)(((2 * u.pm) * 8 + (u.pn - 8)) * 2 + (wc >> 1)) * 128 + wr * 64 + rrow) * 128 + (wc & 1) * 64 + rchunk * 8;
        const size_t aist = isu ? (size_t)HALF * 64 : (size_t)8 * 2 * 128 * 128; const int rst = isu ? 64 : 128;
        f32x4 bv[2][2];
#pragma unroll
        for (int bj = 0; bj < 2; ++bj) { bv[bj][0] = *(const f32x4*)(bias + col0 + bj * HALF); bv[bj][1] = *(const f32x4*)(bias + col0 + bj * HALF + 4); }
#pragma unroll
        for (int ai = 0; ai < 2; ++ai)
#pragma unroll
            for (int m = 0; m < 4; ++m) { const int row = row0 + ai * HALF + m * 16; const float rs = RS[wr * 64 + fr + ai * HALF + m * 16]; float ss = 0.f;
#pragma unroll
                for (int bj = 0; bj < 2; ++bj) { f32x4 v0 = acc[ai][bj][m][0] * rs + bv[bj][0], v1 = acc[ai][bj][m][1] * rs + bv[bj][1];
                    const f32x2 a = gelu_pk((f32x2){v0[0], v0[1]}), b = gelu_pk((f32x2){v0[2], v0[3]}), c = gelu_pk((f32x2){v1[0], v1[1]}), d = gelu_pk((f32x2){v1[2], v1[3]});
                    u32x4 w; w.x = ::pkbf(a.x, a.y); w.y = ::pkbf(b.x, b.y); w.z = ::pkbf(c.x, c.y); w.w = ::pkbf(d.x, d.y);
                    *(LAS u32x4*)(sw + fr * EPISCR_PITCH + bj * 64 + fq * 16) = w;
                    if (!isu) ss += (a.x * a.x + a.y * a.y) + (b.x * b.x + b.y * b.y) + (c.x * c.x + c.y * c.y) + (d.x * d.x + d.y * d.y); }
#pragma unroll
                for (int hh = 0; hh < 2; ++hh) { const u32x4 w = *(const LAS u32x4*)(sw + (hh * 8 + rrow) * EPISCR_PITCH + rchunk * 16);
                    ::st_wt(dst, 16384u * 2048u * 2u, gbase + ai * aist + (size_t)(m * 16 + hh * 8) * rst, w); }
                if (!isu) { ss += __shfl_xor(ss, 16); ss += __shfl_xor(ss, 32); if (fq == 0) SSV[(size_t)row * 32 + (u.pn - 8) * 4 + wc] = ss; } }
    }
};
struct EpiNull {
    static constexpr bool PERM = true, AFTER_DRAIN = false, KHOOK = false;
    __device__ __forceinline__ void pre(int tid) const {  }
    __device__ __forceinline__ void operator()(const f32x4 (&acc)[2][2][4][2], const Unit& u, int wr, int wc, int fr, int fq) const {
#pragma unroll
        for (int ai = 0; ai < 2; ++ai)
#pragma unroll
            for (int bj = 0; bj < 2; ++bj)
#pragma unroll
                for (int m = 0; m < 4; ++m)
#pragma unroll
                    for (int n = 0; n < 2; ++n) asm volatile("" :: "v"(acc[ai][bj][m][n]));
    }
};
}

template <int MT, int STEPS, bool AFRAG> __device__ __forceinline__ f32x4 block_gemm_ks(int wave, int lane, const bf16_t* A, int lda, int row_base, const bf16_t* Wt, int K, int col0, LAS float* red) {
    const int fr = lane & 15, fq = lane >> 4, ksl = K >> 3, nsteps = ksl >> 5;
    const bf16x8* ap = AFRAG ? (const bf16x8*)A + ((size_t)(row_base >> 4) * (K >> 5) + wave * (ksl >> 5)) * 64 + lane
                             : (const bf16x8*)(A + (size_t)(row_base + fr) * lda + wave * ksl + 8 * fq);
    const bf16x8* bp = (const bf16x8*)(Wt + (size_t)(col0 + fr) * K + wave * ksl + 8 * fq);
    const size_t mstride = AFRAG ? (size_t)(K >> 5) * 64 : (size_t)16 * lda / 8; const int sstride = AFRAG ? 64 : 4;
    f32x4 acc[MT];
#pragma unroll
    for (int m = 0; m < MT; ++m) acc[m] = (f32x4){0.f, 0.f, 0.f, 0.f};
    LDS_BARRIER();
#pragma unroll 1
    for (int s0 = 0; s0 < nsteps; s0 += STEPS) {
        bf16x8 bfr[STEPS], afr[MT][STEPS];
#pragma unroll
        for (int s = 0; s < STEPS; ++s) { bfr[s] = bp[4 * (s0 + s)];
#pragma unroll
            for (int m = 0; m < MT; ++m) afr[m][s] = ap[m * mstride + sstride * (s0 + s)]; }
#pragma unroll
        for (int s = 0; s < STEPS; ++s)
#pragma unroll
            for (int m = 0; m < MT; ++m) acc[m] = __builtin_amdgcn_mfma_f32_16x16x32_bf16(bfr[s], afr[m][s], acc[m], 0, 0, 0);
    }
#pragma unroll
    for (int m = 0; m < MT; ++m) *(LAS f32x4*)(red + ((wave * MT + m) * 64 + lane) * 4) = acc[m];
    LDS_BARRIER();
    f32x4 v = (f32x4){0.f, 0.f, 0.f, 0.f};
    if (wave < MT) {
#pragma unroll
        for (int w2 = 0; w2 < 8; ++w2) v = v + *(const LAS f32x4*)(red + ((w2 * MT + wave) * 64 + lane) * 4);
    }
    return v;
}

__device__ __forceinline__ void block_gemm_ks2(int wave, int lane, const bf16_t* A, const bf16_t* Wt, int K, int col0, LAS float* red, f32x4& o0, f32x4& o1) {
    const int fr = lane & 15, fq = lane >> 4, ksl = K >> 3, nsteps = ksl >> 5;
    const bf16x8* ap = (const bf16x8*)A + ((size_t)wave * (ksl >> 5)) * 64 + lane;
    const bf16x8* bp0 = (const bf16x8*)(Wt + (size_t)(col0 + fr) * K + wave * ksl + 8 * fq); const bf16x8* bp1 = (const bf16x8*)(Wt + (size_t)(col0 + 16 + fr) * K + wave * ksl + 8 * fq);
    const size_t mstride = (size_t)(K >> 5) * 64;
    f32x4 acc[8][2];
#pragma unroll
    for (int m = 0; m < 8; ++m) { acc[m][0] = (f32x4){0.f, 0.f, 0.f, 0.f}; acc[m][1] = acc[m][0]; }
    LDS_BARRIER();
#pragma unroll 1
    for (int s0 = 0; s0 < nsteps; s0 += 2) {
        bf16x8 b0[2], b1[2], afr[8][2];
#pragma unroll
        for (int s = 0; s < 2; ++s) { b0[s] = bp0[4 * (s0 + s)]; b1[s] = bp1[4 * (s0 + s)];
#pragma unroll
            for (int m = 0; m < 8; ++m) afr[m][s] = ap[m * mstride + 64 * (s0 + s)]; }
#pragma unroll
        for (int s = 0; s < 2; ++s)
#pragma unroll
            for (int m = 0; m < 8; ++m) { acc[m][0] = __builtin_amdgcn_mfma_f32_16x16x32_bf16(b0[s], afr[m][s], acc[m][0], 0, 0, 0); acc[m][1] = __builtin_amdgcn_mfma_f32_16x16x32_bf16(b1[s], afr[m][s], acc[m][1], 0, 0, 0); }
    }
#pragma unroll
    for (int m = 0; m < 8; ++m) { *(LAS f32x4*)(red + (((wave * 8 + m) * 2 + 0) * 64 + lane) * 4) = acc[m][0]; *(LAS f32x4*)(red + (((wave * 8 + m) * 2 + 1) * 64 + lane) * 4) = acc[m][1]; }
    LDS_BARRIER();
    o0 = (f32x4){0.f, 0.f, 0.f, 0.f}; o1 = o0;
#pragma unroll
    for (int w2 = 0; w2 < 8; ++w2) { o0 = o0 + *(const LAS f32x4*)(red + (((w2 * 8 + wave) * 2 + 0) * 64 + lane) * 4); o1 = o1 + *(const LAS f32x4*)(red + (((w2 * 8 + wave) * 2 + 1) * 64 + lane) * 4); }
}

#define PHASE_CTX(c0) Ctx c = (c0); c.lane = lane_id_fresh(); c.tid = c.wave * 64 + c.lane
struct Ctx {
    const float* in[23]; float* out; unsigned char* ws;
    LAS unsigned char* lds; int tid, lane, wave, blk, G;
};

struct TrItem { const float* W; bf16_t* WT; const float* gk; int K, N, k0, n0, perm; };
__device__ __forceinline__ TrItem tr_decode(const Ctx& c, int it) {
    constexpr int I_SI = 16 * 193, I_SO = 32 * 32, I_CI = 16 * 128, I_CO = 32 * 32, I_UP = 16 * 128, I_DN = 64 * 32;
    constexpr int NITEMS_BEFORE_DN = 2 * I_SI + 2 * I_SO + 2 * I_CI + 2 * I_CO + 4 * I_UP;
    constexpr int NITEMS_BEFORE_CO = 2 * I_SI + 2 * I_SO + 2 * I_CI;
    TrItem t; int r = it, j;
    if (r < 2 * I_SI) { j = r / I_SI; r -= j * I_SI; t.W = c.in[7] + (size_t)j * 1024 * INDIM; t.K = 1024; t.N = INDIM; t.WT = (bf16_t*)(c.ws + WS_WSI + j * WSI_STRIDE); t.gk = c.in[4] + (2 * j) * 1024; }
    else if ((r -= 2 * I_SI) < 2 * I_SO) { j = r / I_SO; r -= j * I_SO; t.W = c.in[14] + (size_t)j * 2048 * 1024; t.K = 2048; t.N = 1024; t.WT = (bf16_t*)(c.ws + WS_WSO + j * WSO_STRIDE); t.gk = c.in[13] + j * 2048; }
    else if ((r -= 2 * I_SO) < 2 * I_CI) { j = r / I_CI; r -= j * I_CI; t.W = c.in[15] + (size_t)j * 1024 * 4096; t.K = 1024; t.N = 4096; t.WT = (bf16_t*)(c.ws + WS_WCI + j * WCI_STRIDE); t.gk = c.in[4] + (2 * j + 1) * 1024; }
    else if ((r -= 2 * I_CI) < 2 * I_CO) { j = r / I_CO; r -= j * I_CO; t.W = c.in[20] + (size_t)j * 2048 * 1024; t.K = 2048; t.N = 1024; t.WT = (bf16_t*)(c.ws + WS_WCO + j * WCO_STRIDE); t.gk = nullptr; }
    else if ((r -= 2 * I_CO) < 4 * I_UP) { j = r / I_UP; r -= j * I_UP; t.W = c.in[21] + (size_t)j * 1024 * 4096; t.K = 1024; t.N = 4096; t.WT = (bf16_t*)(c.ws + WS_WUP + j * WUP_STRIDE); t.gk = c.in[5] + j * 1024; }
    else { r -= 4 * I_UP; j = r / I_DN; r -= j * I_DN; t.W = c.in[22] + (size_t)j * 4096 * 1024; t.K = 4096; t.N = 1024; t.WT = (bf16_t*)(c.ws + WS_WDN + j * WDN_STRIDE); t.gk = nullptr; }
    const int nblk = t.N / 32; t.k0 = 64 * (r / nblk); t.n0 = 32 * (r % nblk); t.perm = (it >= NITEMS_BEFORE_DN || (it >= NITEMS_BEFORE_CO && it < NITEMS_BEFORE_CO + 2 * I_CO)) ? 1 : 0; return t;
}
__device__ __forceinline__ void tr_load(const TrItem& t, int lane, f32x4 (&v)[8], f32x4 (&gv)[2]) {
    const float* p = t.W + t.n0 + 4 * (lane & 7);
#pragma unroll
    for (int i = 0; i < 8; ++i) { const int kp = t.k0 + (lane >> 3) + 8 * i; v[i] = __builtin_nontemporal_load((const f32x4*)(p + (size_t)(t.perm ? log256(kp) : kp) * t.N)); }
    if (t.gk) { gv[0] = *(const f32x4*)(t.gk + t.k0 + 8 * (lane & 7)); gv[1] = *(const f32x4*)(t.gk + t.k0 + 8 * (lane & 7) + 4); }
    else { gv[0] = (f32x4){1.f, 1.f, 1.f, 1.f}; gv[1] = gv[0]; }
}
__device__ __forceinline__ void row_to_bf16_ss(const float* xrow, bf16_t* orow, float* ssrow, int nslots, int lane, int frag_row = -1) {
    const f32x4* xr = (const f32x4*)xrow + lane; float s = 0.f; f32x4 v[4];
#pragma unroll
    for (int j = 0; j < 4; ++j) { v[j] = __builtin_nontemporal_load(xr + 64 * j); s += dot4(v[j]); }
    s = wave_sum(s);
#pragma unroll
    for (int j = 0; j < 4; ++j) { u32x2 w; w.x = pkbf(v[j].x, v[j].y); w.y = pkbf(v[j].z, v[j].w); const int col = 4 * lane + 256 * j; *(u32x2*)(orow + (frag_row >= 0 ? frag_off(frag_row, col, 1024) : (size_t)col)) = w; }
    for (int i = lane; i < nslots; i += 64) ssrow[i] = (i == 0) ? s : 0.f;
}

__device__ __forceinline__ void phase_prologue(const Ctx& c0) {
    PHASE_CTX(c0);
    LAS float* scr = (LAS float*)(c.lds + c.wave * 16384);
    const int gw = c.blk * NWAVES + c.wave, NGW = c.G * NWAVES;
    constexpr int NITEMS = 2 * (16 * 193) + 2 * (32 * 32) + 2 * (16 * 128) + 2 * (32 * 32) + 4 * (16 * 128) + 4 * (64 * 32);
    for (int m0 = 4 * gw; m0 < M; m0 += 4 * NGW) {
        f32x4 v[4][4];
#pragma unroll
        for (int u = 0; u < 4; ++u) { const f32x4* xr = (const f32x4*)(c.in[0] + (size_t)(m0 + u) * D) + c.lane;
#pragma unroll
            for (int jx = 0; jx < 4; ++jx) v[u][jx] = __builtin_nontemporal_load(xr + 64 * jx); }
#pragma unroll
        for (int u = 0; u < 4; ++u) { const int m = m0 + u; bf16_t* orow = (bf16_t*)(c.ws + WS_XB) + (size_t)m * D; float* ssrow = (float*)(c.ws + WS_SS) + (size_t)m * 16;
            float s = 0.f;
#pragma unroll
            for (int jx = 0; jx < 4; ++jx) s += dot4(v[u][jx]);
            s = wave_sum(s);
#pragma unroll
            for (int jx = 0; jx < 4; ++jx) { u32x2 w2; w2.x = pkbf(v[u][jx].x, v[u][jx].y); w2.y = pkbf(v[u][jx].z, v[u][jx].w); *(u32x2*)(orow + 4 * c.lane + 256 * jx) = w2; }
            if (c.lane < 16) ssrow[c.lane] = (c.lane == 0) ? s : 0.f; }
    }
    for (int r = gw; r < MS; r += NGW) row_to_bf16_ss(c.in[1] + (size_t)r * D, (bf16_t*)(c.ws + WS_XSB), (float*)(c.ws + WS_SSS) + (size_t)r * 64, 64, c.lane, r);
    int it = gw; asm volatile("" : "+s"(it));
    if (it < NITEMS) {
        TrItem cur = tr_decode(c, it); f32x4 v[8], gv[2]; tr_load(cur, c.lane, v, gv);
#pragma unroll 1
        for (;;) {
#pragma unroll
            for (int i = 0; i < 8; ++i) { LAS float* s = scr + ((c.lane >> 3) + 8 * i) * 33 + 4 * (c.lane & 7); s[0] = v[i].x; s[1] = v[i].y; s[2] = v[i].z; s[3] = v[i].w; }
            const f32x4 g0 = gv[0], g1 = gv[1]; const TrItem t = cur;
            LDS_WAIT(); asm volatile("" ::: "memory");
            const int nxt = it + NGW; const bool more = nxt < NITEMS;
            if (more) { cur = tr_decode(c, nxt); tr_load(cur, c.lane, v, gv); }
            const int cc = c.lane & 7;
#pragma unroll
            for (int jn = 0; jn < 4; ++jn) { const int n = (c.lane >> 3) + 8 * jn; const LAS float* s = scr + (8 * cc) * 33 + n;
                u32x4 o; o.x = pkbf(s[0 * 33] * g0.x, s[1 * 33] * g0.y); o.y = pkbf(s[2 * 33] * g0.z, s[3 * 33] * g0.w); o.z = pkbf(s[4 * 33] * g1.x, s[5 * 33] * g1.y); o.w = pkbf(s[6 * 33] * g1.z, s[7 * 33] * g1.w);
#ifdef PRO_WT
                st_wt((bf16_t*)c.ws, 0x7ffffff0u, (size_t)(t.WT - (bf16_t*)c.ws) + (size_t)(t.n0 + n) * t.K + t.k0 + 8 * cc, o); }
#else
                *(u32x4*)(t.WT + (size_t)(t.n0 + n) * t.K + t.k0 + 8 * cc) = o; }
#endif
            LDS_WAIT(); asm volatile("" ::: "memory");
            if (!more) break;
            it = nxt;
        }
    }
}

__device__ __forceinline__ void phase_conv(const Ctx& c0, int j) {
    PHASE_CTX(c0);
    const bf16_t* XBC = (const bf16_t*)(c.ws + WS_XBC); bf16_t* XC = (bf16_t*)(c.ws + WS_XC);
    const float* cw = c.in[8] + (size_t)j * 4 * CONVD; const float* cb = c.in[9] + (size_t)j * CONVD;
    LAS float* xs = (LAS float*)c.lds;
    LAS float* yb = xs + 512;
    LAS float* hd = xs + 768;
    LAS float* zb = xs + 784;
    const int w = c.wave;
    const float* XBCS = (const float*)(c.ws + WS_XBCS); const float* DTS = (const float*)(c.ws + WS_DTS); const float* ZSS = (const float*)(c.ws + WS_ZSS);
    bf16_t* YNS = (bf16_t*)(c.ws + WS_YNS);
    const float* cst_in = c.in[3] + (size_t)j * MS * 3 * CONVD; float* cst_out = c.out + O_CONVS + (size_t)j * MS * 3 * CONVD;
    const float* st_in = c.in[2] + (size_t)j * MS * NH * HD * NST; float* st_out = c.out + O_SSMS + (size_t)j * MS * NH * HD * NST;
#define SAMPLE_CONV(sit) do { const int sb_ = (sit) >> 3, g_ = (sit) & 7, t_ = c.tid; \
        const int ch_ = t_ < 256 ? g_ * 256 + t_ : (t_ < 384 ? 2048 + g_ * 128 + (t_ - 256) : 3072 + g_ * 128 + (t_ - 384)); \
        const float* ci_ = cst_in + (size_t)sb_ * 3 * CONVD + ch_; const float c0_ = ci_[0], c1_ = ci_[CONVD], c2_ = ci_[2 * CONVD], xn_ = XBCS[(size_t)sb_ * CONVD + ch_]; \
        xs[t_] = silu_f(cb[ch_] + cw[ch_] * c0_ + cw[CONVD + ch_] * c1_ + cw[2 * CONVD + ch_] * c2_ + cw[3 * CONVD + ch_] * xn_); \
        float* co_ = cst_out + (size_t)sb_ * 3 * CONVD + ch_; co_[0] = c1_; co_[CONVD] = c2_; co_[2 * CONVD] = xn_; \
        if (t_ < 256) zb[t_] = ZSS[(size_t)sb_ * DI + g_ * 256 + t_]; \
        if (t_ < 4) { const int h_ = 4 * g_ + t_; const float dt_ = DTS[sb_ * 32 + h_]; hd[t_] = dt_; hd[4 + t_] = expf(dt_ * -expf(c.in[11][j * NH + h_])); hd[8 + t_] = c.in[12][j * NH + h_]; } } while (0)
    for (int item = c.blk; item < NB * 32; item += c.G) {
        const int bb = c.G == 256 ? (item & 7) : (item >> 5), rb = c.G == 256 ? (item >> 3) : (item & 31), ch = 8 * c.tid;
        const bf16_t* src = XBC + ((size_t)bb * SEQ + rb * 64) * CONVD + phys256(ch);
        const int xrs = ch < 2048 ? 64 : 128;
        bf16_t* dstp = XC + (ch < 2048 ? ((size_t)(bb * NH + (ch >> 6)) * SEQ + rb * 64) * 64 + (ch & 63)
                                     : (ch < 3072 ? XC_BOFF : XC_COFF) + ((size_t)(bb * NG + (((ch - 2048) & 1023) >> 7)) * SEQ + rb * 64) * 128 + (ch & 127));
        f32x4 wv[4][2], bia[2], win[3][2];
#pragma unroll
        for (int k = 0; k < 4; ++k) { wv[k][0] = *(const f32x4*)(cw + k * CONVD + ch); wv[k][1] = *(const f32x4*)(cw + k * CONVD + ch + 4); }
        bia[0] = *(const f32x4*)(cb + ch); bia[1] = *(const f32x4*)(cb + ch + 4);
#pragma unroll
        for (int i = 0; i < 3; ++i) { u32x4 r = (u32x4){0u, 0u, 0u, 0u}; if (rb > 0) r = *(const u32x4*)(src + (ptrdiff_t)(i - 3) * CONVD);
            win[i][0] = (f32x4){bf_lo(r.x), bf_hi(r.x), bf_lo(r.y), bf_hi(r.y)}; win[i][1] = (f32x4){bf_lo(r.z), bf_hi(r.z), bf_lo(r.w), bf_hi(r.w)}; }
        SAMPLE_CONV(item * 4);
        f32x4 st[4];
        { const int sit0 = item * 4, ssb0 = sit0 >> 3, sh0 = 4 * (sit0 & 7); const size_t sb0 = (((size_t)ssb0 * NH + sh0) * HD + 8 * w + (c.lane >> 5)) * NST + 4 * (c.lane & 31);
#pragma unroll
          for (int i = 0; i < 4; ++i) st[i] = __builtin_nontemporal_load((const f32x4*)(st_in + sb0 + (size_t)(2 * i) * NST)); }
        u32x4 rawn[4];
#pragma unroll
        for (int i = 0; i < 4; ++i) rawn[i] = __builtin_nontemporal_load((const u32x4*)(src + (size_t)i * CONVD));
        LDS_BARRIER();
#pragma unroll 1
        for (int ck = 0; ck < 16; ++ck) {
            u32x4 raw[4];
#pragma unroll
            for (int i = 0; i < 4; ++i) raw[i] = rawn[i];
            if (ck + 1 < 16) {
#pragma unroll
                for (int i = 0; i < 4; ++i) rawn[i] = __builtin_nontemporal_load((const u32x4*)(src + (size_t)(4 * (ck + 1) + i) * CONVD)); }
            { const int sit = item * 4 + (ck >> 2), ssb = sit >> 3, sg = sit & 7, r = ck & 3, sh = 4 * sg + r, half = c.lane >> 5, nq = c.lane & 31;
              const size_t sbase = (((size_t)ssb * NH + sh) * HD + 8 * w + half) * NST + 4 * nq;
              const float dt = hd[r], dA = hd[4 + r], Dsh = hd[8 + r];
              const f32x4 B4 = *(const LAS f32x4*)(xs + 256 + 4 * nq), C4 = *(const LAS f32x4*)(xs + 384 + 4 * nq);
#pragma unroll
              for (int i = 0; i < 4; ++i) { const int p = 8 * w + 2 * i + half; const float xp = xs[r * 64 + p];
                  const f32x4 hn = st[i] * dA + B4 * (dt * xp);
                  __builtin_nontemporal_store(hn, (f32x4*)(st_out + sbase + (size_t)(2 * i) * NST));
                  float part = (C4.x * hn.x + C4.y * hn.y) + (C4.z * hn.z + C4.w * hn.w);
                  part += __shfl_xor(part, 1); part += __shfl_xor(part, 2); part += __shfl_xor(part, 4); part += __shfl_xor(part, 8); part += __shfl_xor(part, 16);
                  if (nq == 0) yb[r * 64 + p] = (part + Dsh * xp) * zb[r * 64 + p]; }
              if (ck + 1 < 16) { const int sit1 = item * 4 + ((ck + 1) >> 2), ssb1 = sit1 >> 3, sh1 = 4 * (sit1 & 7) + ((ck + 1) & 3); const size_t sb1 = (((size_t)ssb1 * NH + sh1) * HD + 8 * w + half) * NST + 4 * nq;
#pragma unroll
                  for (int i = 0; i < 4; ++i) st[i] = __builtin_nontemporal_load((const f32x4*)(st_in + sb1 + (size_t)(2 * i) * NST)); } }
#pragma unroll
            for (int i = 0; i < 4; ++i) { const u32x4 r = raw[i];
                const f32x4 c0v = (f32x4){bf_lo(r.x), bf_hi(r.x), bf_lo(r.y), bf_hi(r.y)}, c1v = (f32x4){bf_lo(r.z), bf_hi(r.z), bf_lo(r.w), bf_hi(r.w)};
                f32x4 o0 = bia[0] + wv[0][0] * win[0][0] + wv[1][0] * win[1][0] + wv[2][0] * win[2][0] + wv[3][0] * c0v;
                f32x4 o1 = bia[1] + wv[0][1] * win[0][1] + wv[1][1] * win[1][1] + wv[2][1] * win[2][1] + wv[3][1] * c1v;
                win[0][0] = win[1][0]; win[0][1] = win[1][1]; win[1][0] = win[2][0]; win[1][1] = win[2][1]; win[2][0] = c0v; win[2][1] = c1v;
                u32x4 q; q.x = pkbf(silu_f(o0[0]), silu_f(o0[1])); q.y = pkbf(silu_f(o0[2]), silu_f(o0[3])); q.z = pkbf(silu_f(o1[0]), silu_f(o1[1])); q.w = pkbf(silu_f(o1[2]), silu_f(o1[3]));
#ifdef XC_WT
                st_wt(XC, 16384u * 4096u * 2u, (size_t)(dstp - XC) + (size_t)(4 * ck + i) * xrs, q); }
#else
                *(u32x4*)(dstp + (size_t)(4 * ck + i) * xrs) = q; }
#endif
            LDS_BARRIER();
            if ((ck & 3) == 3) {
                const int sit = item * 4 + (ck >> 2), ssb = sit >> 3, sg = sit & 7;
                const f32x4 yv4 = *(const LAS f32x4*)(yb + 4 * c.lane); const float tot = wave_sum(dot4(yv4)); const float rs = rsqrtf(tot * (1.f / 256.f) + EPS);
                if (c.lane < 16) { const int i2 = w * 32 + 2 * c.lane; *(unsigned*)(YNS + frag_off(ssb, sg * 256 + i2, DI)) = pkbf(yb[i2] * rs, yb[i2 + 1] * rs); }
                if (ck + 1 < 16) SAMPLE_CONV(sit + 1);
            }
            LDS_BARRIER();
        }
    }
#undef SAMPLE_CONV
}

__device__ __forceinline__ u32x4 tr8_col(const u32x4 (&raw)[8], int jj) {
    unsigned e[8];
#pragma unroll
    for (int i = 0; i < 8; ++i) { const unsigned wd = (jj >> 1) == 0 ? raw[i].x : ((jj >> 1) == 1 ? raw[i].y : ((jj >> 1) == 2 ? raw[i].z : raw[i].w)); e[i] = (jj & 1) ? (wd >> 16) : (wd & 0xffffu); }
    u32x4 o; o.x = e[0] | (e[1] << 16); o.y = e[2] | (e[3] << 16); o.z = e[4] | (e[5] << 16); o.w = e[6] | (e[7] << 16); return o;
}

typedef short v4i16_t __attribute__((ext_vector_type(4)));
__device__ __forceinline__ bf16x8 lds_tr_frag(const LAS unsigned char* tile, int pitch, int k0, int n0, int lane) {
    const int g = lane >> 4, q = (lane & 15) >> 2, p = lane & 3;
    const LAS unsigned char* a = tile + (k0 + 8 * g + q) * pitch + (n0 + 4 * p) * 2;
    const v4i16_t lo = __builtin_amdgcn_ds_read_tr16_b64_v4i16((LAS v4i16_t*)a);
    const v4i16_t hi = __builtin_amdgcn_ds_read_tr16_b64_v4i16((LAS v4i16_t*)(a + 4 * pitch));
    return (bf16x8){lo[0], lo[1], lo[2], lo[3], hi[0], hi[1], hi[2], hi[3]};
}
__device__ __forceinline__ bf16x8 lds_tr_frag_perm(const LAS unsigned char* tile, int pitch, int k0, int n0, int lane) {
    const int g = lane >> 4, q = (lane & 15) >> 2, p = lane & 3;
    const LAS unsigned char* a = tile + (k0 + 4 * g + q) * pitch + (n0 + 4 * p) * 2;
    const v4i16_t lo = __builtin_amdgcn_ds_read_tr16_b64_v4i16((LAS v4i16_t*)a);
    const v4i16_t hi = __builtin_amdgcn_ds_read_tr16_b64_v4i16((LAS v4i16_t*)(a + 16 * pitch));
    return (bf16x8){lo[0], lo[1], lo[2], lo[3], hi[0], hi[1], hi[2], hi[3]};
}
__device__ __forceinline__ void phase_ssd_scan(const Ctx& c0, int j) {
    PHASE_CTX(c0);
    const bf16_t* XC = (const bf16_t*)(c.ws + WS_XC); const float* DT = (const float*)(c.ws + WS_DT); const bf16_t* ZS = (const bf16_t*)(c.ws + WS_ZS);
    bf16_t* YN = (bf16_t*)(c.ws + WS_YN); float* SSY = (float*)(c.ws + WS_SSY);
    constexpr int XP = 144;
    LAS unsigned char* RC = c.lds;
    LAS unsigned char* RB = c.lds + 34816;
    LAS unsigned char* RX = c.lds + 69632;
    LAS unsigned char* RX2 = c.lds + 88064;
    LAS unsigned char* RH = c.lds + 106496;
    LAS float* scl = (LAS float*)(c.lds + 123904);
    const int w = c.wave;
    const int rt = (w < 4) ? w : 11 - w;
    for (int item_ = c.blk; item_ < NB * NH; item_ += c.G) {
        const int item = ((item_ & 7) << 5) | (item_ >> 3);
        const int bb = item >> 5, h = item & 31, g = h >> 2;
        const float Ah = -expf(c.in[11][j * NH + h]), Dh = c.in[12][j * NH + h];
        f32x4 hs[4];
#pragma unroll
        for (int t = 0; t < 4; ++t) hs[t] = (f32x4){0.f, 0.f, 0.f, 0.f};
        const int pt = w & 3, nt0 = 4 * (w >> 2);
        u32x4 ncp[4], nbp[4], nxp[4]; u32x2 nzz[4]; float nd0 = 0.f, nd1 = 0.f;
#define STAGE_LOADS(ck) do { \
            _Pragma("unroll") for (int i = 0; i < 4; ++i) { const int pc_ = c.tid + 512 * i, rw_ = pc_ >> 4, cc_ = pc_ & 15; \
                ncp[i] = *(const u32x4*)(XC + XC_COFF + ((size_t)(bb * NG + g) * SEQ + (ck) * CH + rw_) * 128 + cc_ * 8); nbp[i] = *(const u32x4*)(XC + XC_BOFF + ((size_t)(bb * NG + g) * SEQ + (ck) * CH + rw_) * 128 + cc_ * 8); } \
            if (w < 4) { _Pragma("unroll") for (int i = 0; i < 4; ++i) { const int px_ = c.tid + 256 * i, rw_ = px_ >> 3, cc_ = px_ & 7; nxp[i] = __builtin_nontemporal_load((const u32x4*)(XC + ((size_t)(bb * NH + h) * SEQ + (ck) * CH + rw_) * 64 + cc_ * 8)); } } \
            { const int q_ = 16 * rt + (c.lane & 15); _Pragma("unroll") for (int p4 = 0; p4 < 4; ++p4) nzz[p4] = __builtin_nontemporal_load((const u32x2*)(ZS + ((size_t)bb * SEQ + (ck) * CH + q_) * DI + phys256(h * 64 + 16 * p4 + 4 * (c.lane >> 4)))); } \
            if (w == 1) { const float* dp_ = DT + ((size_t)bb * SEQ + (ck) * CH + 2 * c.lane) * 32 + h; nd0 = dp_[0]; nd1 = dp_[32]; } } while (0)
#define SSD_SCALE(ck) do { const int s0 = 2 * c.lane; const float d0 = nd0, d1 = nd1; const float a0 = d0 * (Ah * 1.4426950408889634f), a1 = d1 * (Ah * 1.4426950408889634f); float run = a0 + a1;     \
            _Pragma("unroll") for (int o = 1; o < 64; o <<= 1) { const float t_ = __shfl_up(run, o); if (c.lane >= o) run += t_; } \
            const float tot = __shfl(run, 63); const float ac1 = run, ac0 = run - a1; \
            LAS float* sb_ = scl + ((ck) & 1) * 400; sb_[s0] = ac0; sb_[s0 + 1] = ac1; sb_[128 + s0] = ac0 - __builtin_amdgcn_logf(d0); sb_[128 + s0 + 1] = ac1 - __builtin_amdgcn_logf(d1);     \
            sb_[256 + s0] = d0 * __builtin_amdgcn_exp2f(tot - ac0); sb_[256 + s0 + 1] = d1 * __builtin_amdgcn_exp2f(tot - ac1); if (c.lane == 0) sb_[384] = __builtin_amdgcn_exp2f(tot); } while (0)
        STAGE_LOADS(0);
        if (w == 1) SSD_SCALE(0);
        __syncthreads();
        for (int ck = 0; ck < NCHUNK; ++ck) {
            { int lz_ = c.lane; asm volatile("" : "+v"(lz_)); c.lane = lz_; c.tid = w * 64 + lz_; }
            const int fr = c.lane & 15, fq = c.lane >> 4, q = 16 * rt + fr;
            const LAS float* sb = scl + (ck & 1) * 400;
            const size_t row0 = (size_t)bb * SEQ + ck * CH;
#pragma unroll
            for (int i = 0; i < 4; ++i) { const int pc = c.tid + 512 * i, rw = pc >> 4, cc = pc & 15; *(LAS u32x4*)(RC + rw * TP + cc * 16) = ncp[i]; *(LAS u32x4*)(RB + rw * TP + cc * 16) = nbp[i]; }
            if (w < 4) {
#pragma unroll
                for (int i = 0; i < 4; ++i) { const int px = c.tid + 256 * i, rw = px >> 3, cc = px & 7; const u32x4 r = nxp[i]; const float sc = sb[256 + rw];
                    *(LAS u32x4*)(RX + rw * XP + cc * 16) = r;
                    u32x4 s4; s4.x = pkbf(bf_lo(r.x) * sc, bf_hi(r.x) * sc); s4.y = pkbf(bf_lo(r.y) * sc, bf_hi(r.y) * sc); s4.z = pkbf(bf_lo(r.z) * sc, bf_hi(r.z) * sc); s4.w = pkbf(bf_lo(r.w) * sc, bf_hi(r.w) * sc);
                    *(LAS u32x4*)(RX2 + rw * XP + cc * 16) = s4; } }
#pragma unroll
            for (int t = 0; t < 4; ++t) { u32x2 o; o.x = pkbf(hs[t][0], hs[t][1]); o.y = pkbf(hs[t][2], hs[t][3]); *(LAS u32x2*)(RH + (16 * pt + fr) * TP + (16 * (nt0 + t) + 4 * fq) * 2) = o; }
            __syncthreads();
            u32x2 zz[4];
#pragma unroll
            for (int p4 = 0; p4 < 4; ++p4) zz[p4] = nzz[p4];
            if (ck + 1 < NCHUNK) STAGE_LOADS(ck + 1);
            bf16x8 cfr[4];
#pragma unroll
            for (int ks = 0; ks < 4; ++ks) cfr[ks] = *(const LAS bf16x8*)(RC + q * TP + (32 * ks + 8 * fq) * 2);
            f32x4 ao[4];
#pragma unroll
            for (int p4 = 0; p4 < 4; ++p4) { ao[p4] = (f32x4){0.f, 0.f, 0.f, 0.f};
#pragma unroll
                for (int ks = 0; ks < 4; ++ks) { const bf16x8 hf = *(const LAS bf16x8*)(RH + (16 * p4 + fr) * TP + (32 * ks + 8 * fq) * 2); ao[p4] = __builtin_amdgcn_mfma_f32_16x16x32_bf16(hf, cfr[ks], ao[p4], 0, 0, 0); } }
            const float aq = sb[q];
            const int npm1 = rt >> 1;
            f32x4 ay[4];
#pragma unroll
            for (int p4 = 0; p4 < 4; ++p4) ay[p4] = (f32x4){0.f, 0.f, 0.f, 0.f};
            {
                bf16x8 b0[4], b1[4], xc[4]; f32x4 as0, ds0, as1, ds1;
#define SCAN_LOADP(u_) do { _Pragma("unroll") for (int ks = 0; ks < 4; ++ks) { b0[ks] = *(const LAS bf16x8*)(RB + (32 * (u_) + fr) * TP + (32 * ks + 8 * fq) * 2); b1[ks] = *(const LAS bf16x8*)(RB + (32 * (u_) + 16 + fr) * TP + (32 * ks + 8 * fq) * 2); } \
                    as0 = *(const LAS f32x4*)(sb + 32 * (u_) + 4 * fq); as1 = *(const LAS f32x4*)(sb + 32 * (u_) + 16 + 4 * fq); ds0 = *(const LAS f32x4*)(sb + 128 + 32 * (u_) + 4 * fq); ds1 = *(const LAS f32x4*)(sb + 128 + 32 * (u_) + 16 + 4 * fq); } while (0)
#define SCAN_LOADX(u_) do { _Pragma("unroll") for (int p4 = 0; p4 < 4; ++p4) xc[p4] = lds_tr_frag_perm(RX, XP, 32 * (u_), 16 * p4, c.lane); } while (0)
                SCAN_LOADP(0); SCAN_LOADX(0);
#pragma unroll 1
                for (int u = 0; ; ++u) {
                    f32x4 c0 = (f32x4){0.f, 0.f, 0.f, 0.f}, c1 = c0;
#pragma unroll
                    for (int ks = 0; ks < 4; ++ks) { c0 = __builtin_amdgcn_mfma_f32_16x16x32_bf16(b0[ks], cfr[ks], c0, 0, 0, 0); c1 = __builtin_amdgcn_mfma_f32_16x16x32_bf16(b1[ks], cfr[ks], c1, 0, 0, 0); }
                    const f32x4 a0 = as0, d0 = ds0, a1 = as1, d1 = ds1;
                    const bool lastp = (u == npm1);
                    if (!lastp) SCAN_LOADP(u + 1);
                    float l0[4], l1[4];
#pragma unroll
                    for (int e = 0; e < 4; ++e) {
                        l0[e] = c0[e] * __builtin_amdgcn_exp2f(aq - d0[e]); l1[e] = c1[e] * __builtin_amdgcn_exp2f(aq - d1[e]); }
                    if (lastp) {
#pragma unroll
                        for (int e = 0; e < 4; ++e) { const int s = 32 * u + 4 * fq + e; l0[e] = (s <= q) ? l0[e] : 0.f; l1[e] = (s + 16 <= q) ? l1[e] : 0.f; } }
                    u32x4 lo4; lo4.x = pkbf(l0[0], l0[1]); lo4.y = pkbf(l0[2], l0[3]); lo4.z = pkbf(l1[0], l1[1]); lo4.w = pkbf(l1[2], l1[3]);
                    const bf16x8 lfr = __builtin_bit_cast(bf16x8, lo4);
#pragma unroll
                    for (int p4 = 0; p4 < 4; ++p4) ay[p4] = __builtin_amdgcn_mfma_f32_16x16x32_bf16(xc[p4], lfr, ay[p4], 0, 0, 0);
                    if (lastp) break;
                    SCAN_LOADX(u + 1);
                }
#undef SCAN_LOADP
#undef SCAN_LOADX
            }
            const float eq = __builtin_amdgcn_exp2f(aq); float ssq = 0.f;
#pragma unroll
            for (int p4 = 0; p4 < 4; ++p4) {
                const int pc = 16 * p4 + 4 * fq; const float zf[4] = {bf_lo(zz[p4].x), bf_hi(zz[p4].x), bf_lo(zz[p4].y), bf_hi(zz[p4].y)}; float yv[4];
                const u32x2 xr = *(const LAS u32x2*)(RX + q * XP + pc * 2); const float xf4[4] = {bf_lo(xr.x), bf_hi(xr.x), bf_lo(xr.y), bf_hi(xr.y)};
#pragma unroll
                for (int e = 0; e < 4; ++e) { const float y = (ay[p4][e] + eq * ao[p4][e] + Dh * xf4[e]) * zf[e]; yv[e] = y; ssq += y * y; }
                u32x2 o; o.x = pkbf(yv[0], yv[1]); o.y = pkbf(yv[2], yv[3]); *(u32x2*)(YN + ((size_t)(((row0 + q) >> 8) * 32 + h) * 256 + ((row0 + q) & 255)) * 64 + pc) = o;
            }
            ssq += __shfl_xor(ssq, 16); ssq += __shfl_xor(ssq, 32);
            if (fq == 0) SSY[(row0 + q) * 32 + h] = ssq;
            {
                f32x4 S[4];
#pragma unroll
                for (int t = 0; t < 4; ++t) S[t] = (f32x4){0.f, 0.f, 0.f, 0.f};
#pragma unroll
                for (int ks = 0; ks < 4; ++ks) { const bf16x8 a = lds_tr_frag(RX2, XP, 32 * ks, 16 * pt, c.lane);
#pragma unroll
                    for (int t = 0; t < 4; ++t) { const bf16x8 b2 = lds_tr_frag(RB, TP, 32 * ks, 16 * (nt0 + t), c.lane); S[t] = __builtin_amdgcn_mfma_f32_16x16x32_bf16(b2, a, S[t], 0, 0, 0); } }
                const float cdec = sb[384];
#pragma unroll
                for (int t = 0; t < 4; ++t) hs[t] = hs[t] * cdec + S[t];
            }
            if (w == 1 && ck + 1 < NCHUNK) SSD_SCALE(ck + 1);
            __syncthreads();
        }
#undef SSD_SCALE
#undef STAGE_LOADS
        { int lz = c.lane; asm volatile("" : "+v"(lz));
          float* so = c.out + O_SSMP + ((((size_t)j * NB + bb) * NH + h) * HD + 16 * pt + (lz & 15)) * NST + 16 * nt0 + 4 * (lz >> 4);
#pragma unroll
          for (int t = 0; t < 4; ++t) __builtin_nontemporal_store(hs[t], (f32x4*)(so + 16 * t)); }
    }
}

__device__ __forceinline__ void phase_cm_mix(const Ctx& c0, int j, bf16_t* Uout, bool do_sample) {
    PHASE_CTX(c0);
    const bf16_t* U = (const bf16_t*)(c.ws + WS_ZS); const bf16_t* GV = (const bf16_t*)(c.ws + WS_XBC); const float* SSV = (const float*)(c.ws + WS_SSV);
    const float* vg = c.in[17] + (size_t)j * CW; const float* bs = c.in[19] + (size_t)j * NG * CH; const float* wsm = c.in[18] + (size_t)j * NG * CH * CH;
    LAS unsigned char* GT = c.lds;
    LAS float* rsv = (LAS float*)(c.lds + 104448);
#define MIX_ITEM(k_) (c.G == 256 ? (((c.blk & 7) << 7) | ((c.blk >> 3) + 32 * (k_))) : (c.blk + (k_) * c.G))
    const int w = c.wave, rt = (w < 4) ? w : 11 - w, fr = c.lane & 15, fq = c.lane >> 4, q = 16 * rt + fr;
    if (do_sample && c.blk < MS) { const int row = c.blk; const float* GVS = (const float*)(c.ws + WS_GVS); bf16_t* US = (bf16_t*)(c.ws + WS_US);
        const float rs = row_rstd((const float*)(c.ws + WS_SSVS), 32, row, 1.f / 2048.f);
        const int d0 = 4 * c.tid, g = d0 >> 8; const f32x4 gv = *(const f32x4*)(GVS + (size_t)row * CW + d0), vgv = *(const f32x4*)(vg + d0);
        const f32x4 v = gv * rs * vgv; *(f32x4*)(c.out + O_CMV + ((size_t)j * MS + row) * CW + d0) = v;
        const float w00 = wsm[(size_t)g * CH * CH], b0 = bs[g * CH];
        const u32x2 uu = *(const u32x2*)(US + frag_off(row, phys256(d0), CW)); const f32x4 sv = v * w00 + b0;
        u32x2 o; o.x = pkbf(bf_lo(uu.x) * sv.x, bf_hi(uu.x) * sv.y); o.y = pkbf(bf_lo(uu.y) * sv.z, bf_hi(uu.y) * sv.w); *(u32x2*)(US + frag_off(row, phys256(d0), CW)) = o; }
    { const int k = c.tid >> 7, item = MIX_ITEM(k); if (c.blk + k * c.G < NB * NCHUNK * NG) { const int rowk = (item >> 7) * SEQ + ((item >> 3) & 15) * CH + (c.tid & 127); rsv[c.tid] = row_rstd(SSV, 8, rowk, 1.f / 2048.f); } }
    __syncthreads();
    constexpr int NIT = NB * NCHUNK * NG;
    const int nh = c.blk < NIT ? 2 * ((NIT - 1 - c.blk) / c.G + 1) : 0;
    LAS unsigned char* usw = c.lds + 108544 + w * 4352;
    u32x4 raw[4], ur[4];
    float wfl[4][8]; bf16x8 wf[4]; float bq = 0.f; int gcur = -1;
#pragma unroll
    for (int ks = 0; ks < 4; ++ks) { wf[ks] = (bf16x8){0, 0, 0, 0, 0, 0, 0, 0};
#pragma unroll
        for (int e = 0; e < 8; ++e) wfl[ks][e] = 0.f; }
#define MIX_LOADS(hh) do { const int it_ = MIX_ITEM((hh) >> 1), g_ = it_ & 7, hp_ = (hh) & 1; const size_t r0_ = (size_t)(it_ >> 7) * SEQ + ((it_ >> 3) & 15) * CH; \
        _Pragma("unroll") for (int i = 0; i < 4; ++i) { const int pid = c.tid + 512 * i; raw[i] = __builtin_nontemporal_load((const u32x4*)(GV + ((size_t)(((it_ >> 3) * 8 + g_) * 2 + hp_) * 128) * 128 + pid * 8)); } \
        _Pragma("unroll") for (int i = 0; i < 4; ++i) { const size_t rw_ = r0_ + 16 * rt + 4 * i + fq; ur[i] = __builtin_nontemporal_load((const u32x4*)(U + ((size_t)((rw_ >> 8) * 32 + g_ * 4 + 2 * hp_ + (fr >> 3)) * 256 + (rw_ & 255)) * 64 + (fr & 7) * 8)); } } while (0)
    if (nh > 0) MIX_LOADS(0);
#pragma unroll 1
    for (int h_ = 0; h_ < nh; ++h_) {
        int h = h_; asm volatile("" : "+s"(h));
        const int item = MIX_ITEM(h >> 1), hp = h & 1, g = item & 7;
        const size_t row0 = (size_t)(item >> 7) * SEQ + ((item >> 3) & 15) * CH;
        LAS unsigned char* gt = GT + (h & 1) * (128 * TP);
        if (hp == 0) {
            if (g != gcur) { gcur = g;
#pragma unroll
                for (int ks = 0; ks < 4; ++ks) { const int s0 = 32 * ks + 8 * fq; const float* wp = wsm + ((size_t)g * CH + q) * CH + s0; const f32x4 a = *(const f32x4*)wp, bb4 = *(const f32x4*)(wp + 4);
#pragma unroll
                    for (int e = 0; e < 4; ++e) { wfl[ks][e] = (s0 + e <= q) ? a[e] : 0.f; wfl[ks][4 + e] = (s0 + 4 + e <= q) ? bb4[e] : 0.f; } } }
            bq = bs[g * CH + q];
            const LAS float* rsk = rsv + ((h >> 1) & 3) * 128;
#pragma unroll
            for (int ks = 0; ks < 4; ++ks) { const f32x4 r0 = *(const LAS f32x4*)(rsk + 32 * ks + 8 * fq), r1 = *(const LAS f32x4*)(rsk + 32 * ks + 8 * fq + 4);
                u32x4 o; o.x = pkbf(wfl[ks][0] * r0[0], wfl[ks][1] * r0[1]); o.y = pkbf(wfl[ks][2] * r0[2], wfl[ks][3] * r0[3]); o.z = pkbf(wfl[ks][4] * r1[0], wfl[ks][5] * r1[1]); o.w = pkbf(wfl[ks][6] * r1[2], wfl[ks][7] * r1[3]);
                wf[ks] = __builtin_bit_cast(bf16x8, o); }
        }
#pragma unroll
        for (int i = 0; i < 4; ++i) { const int pid = c.tid + 512 * i; *(LAS u32x4*)(gt + (pid >> 4) * TP + (pid & 15) * 16) = raw[i]; }
#pragma unroll
        for (int i = 0; i < 4; ++i) *(LAS u32x4*)(usw + (4 * i + fq) * TP + fr * 16) = ur[i];
        asm volatile("s_waitcnt lgkmcnt(0)" ::: "memory"); __builtin_amdgcn_s_barrier(); asm volatile("" ::: "memory");
        if (h + 1 < nh) MIX_LOADS(h + 1);
        f32x4 vgvr[8];
#pragma unroll
        for (int k = 0; k < 8; ++k) { const int t = 8 * (k >> 2) + 4 * hp + (k & 3); vgvr[k] = *(const f32x4*)(vg + g * 256 + 16 * t + 4 * fq); }
        f32x4 acc[8];
#pragma unroll
        for (int k = 0; k < 8; ++k) acc[k] = (f32x4){0.f, 0.f, 0.f, 0.f};
#pragma unroll
        for (int ks = 0; ks < 4; ++ks) {
            if (ks <= (rt >> 1)) {
#pragma unroll
                for (int k = 0; k < 8; ++k) { const bf16x8 gf = lds_tr_frag(gt, TP, 32 * ks, 64 * ((k >> 1) & 1) + 32 * (k >> 2) + 16 * (k & 1), c.lane); acc[k] = __builtin_amdgcn_mfma_f32_16x16x32_bf16(gf, wf[ks], acc[k], 0, 0, 0); } } }
#pragma unroll
        for (int k = 0; k < 8; ++k) { const int so = (64 * ((k >> 1) & 1) + 32 * (k >> 2) + 16 * (k & 1) + 4 * fq) * 2;
            const u32x2 u2 = *(const LAS u32x2*)(usw + fr * TP + so); const f32x4 sv = acc[k] * vgvr[k] + bq;
            u32x2 o; o.x = pkbf(bf_lo(u2.x) * sv.x, bf_hi(u2.x) * sv.y); o.y = pkbf(bf_lo(u2.y) * sv.z, bf_hi(u2.y) * sv.w); *(LAS u32x2*)(usw + fr * TP + so) = o; }
#pragma unroll
        for (int i = 0; i < 4; ++i) { const u32x4 o4 = *(const LAS u32x4*)(usw + (4 * i + fq) * TP + fr * 16);
            const size_t rw = row0 + 16 * rt + 4 * i + fq; *(u32x4*)(Uout + ((size_t)((rw >> 8) * 32 + g * 4 + 2 * hp + (fr >> 3)) * 256 + (rw & 255)) * 64 + (fr & 7) * 8) = o4; }
    }
#undef MIX_LOADS
#undef MIX_ITEM
    __syncthreads();
}

__device__ __forceinline__ void sample_resid(const Ctx& c0, const bf16_t* A, int K, const bf16_t* Wt, const float* base, size_t dummy_off = 0) {
    PHASE_CTX(c0);
    float* XS = (float*)(c.ws + WS_XS + dummy_off); bf16_t* XSB = (bf16_t*)(c.ws + WS_XSB + dummy_off); float* SSS = (float*)(c.ws + WS_SSS + dummy_off);
    const int fr = c.lane & 15, fq = c.lane >> 4;
    for (int task = c.blk; task < 256; task += c.G) { const int tile = task & 63, rq = task >> 6;
        f32x4 bv = (f32x4){0.f, 0.f, 0.f, 0.f}; if (c.wave < 2) bv = *(const f32x4*)(base + (size_t)(32 * rq + 16 * c.wave + fr) * D + 16 * tile + 4 * fq);
        const f32x4 a = block_gemm_ks<2, 8, true>(c.wave, c.lane, A, K, 32 * rq, Wt, K, 16 * tile, (LAS float*)c.lds);
        if (c.wave < 2) { const int row = 32 * rq + 16 * c.wave + fr, col = 16 * tile + 4 * fq; const f32x4 v = a + bv;
            *(f32x4*)(XS + (size_t)row * D + col) = v; u32x2 o; o.x = pkbf(v.x, v.y); o.y = pkbf(v.z, v.w); *(u32x2*)(XSB + frag_off(row, col, D)) = o;
            float ss = dot4(v); ss += __shfl_xor(ss, 16); ss += __shfl_xor(ss, 32); if (fq == 0) SSS[row * 64 + tile] = ss; } }
    LDS_BARRIER();
}
__device__ __forceinline__ void sample_ssd_in(const Ctx& c0, int j) {
    PHASE_CTX(c0);
    const bf16_t* XSB = (const bf16_t*)(c.ws + WS_XSB); const float* SSS = (const float*)(c.ws + WS_SSS); const bf16_t* Wt = (const bf16_t*)(c.ws + WS_WSI + j * WSI_STRIDE);
    float* ZSS = (float*)(c.ws + WS_ZSS); float* XBCS = (float*)(c.ws + WS_XBCS); float* DTS = (float*)(c.ws + WS_DTS);
    const int fr = c.lane & 15, fq = c.lane >> 4; const int row = 16 * c.wave + fr; const float rs = row_rstd(SSS, 16, row, 1.f / 1024.f);
    for (int pair = c.blk; pair < INDIM / 32; pair += c.G) {
        f32x4 vv[2]; block_gemm_ks2(c.wave, c.lane, XSB, Wt, D, 32 * pair, (LAS float*)c.lds, vv[0], vv[1]);
#pragma unroll
        for (int e2 = 0; e2 < 2; ++e2) { f32x4 v = vv[e2] * rs; const int col = 32 * pair + 16 * e2 + 4 * fq;
            if (col < DI) { v.x = silu_f(v.x); v.y = silu_f(v.y); v.z = silu_f(v.z); v.w = silu_f(v.w); *(f32x4*)(ZSS + (size_t)row * DI + col) = v; }
            else if (col < INMAIN) *(f32x4*)(XBCS + (size_t)row * CONVD + col - DI) = v;
            else { const int h = col - INMAIN; const f32x4 b = *(const f32x4*)(c.in[10] + j * NH + h); v.x = softplus_f(v.x + b.x); v.y = softplus_f(v.y + b.y); v.z = softplus_f(v.z + b.z); v.w = softplus_f(v.w + b.w); *(f32x4*)(DTS + row * 32 + h) = v; } } }
    LDS_BARRIER();
}
__device__ __forceinline__ void prompt_dt(const Ctx& c0, int j) {
    PHASE_CTX(c0);
    const bf16_t* XB = (const bf16_t*)(c.ws + WS_XB); const float* SS = (const float*)(c.ws + WS_SS); const bf16_t* Wt = (const bf16_t*)(c.ws + WS_WSI + j * WSI_STRIDE) + (size_t)INMAIN * D;
    float* DT = (float*)(c.ws + WS_DT); const int fr = c.lane & 15, fq = c.lane >> 4;
    for (int task = c.blk; task < 256; task += c.G) { const int r0 = (task >> 1) * 128, ct = task & 1;
        const int row = r0 + 16 * c.wave + fr, h = 16 * ct + 4 * fq; const float rs = row_rstd(SS, 4, row, 1.f / 1024.f); const f32x4 b = *(const f32x4*)(c.in[10] + j * NH + h);
        const f32x4 a = block_gemm_ks<8, 4, false>(c.wave, c.lane, XB, D, r0, Wt, D, 16 * ct, (LAS float*)c.lds);
        f32x4 v = a * rs + b;
        v.x = softplus_f(v.x); v.y = softplus_f(v.y); v.z = softplus_f(v.z); v.w = softplus_f(v.w); *(f32x4*)(DT + (size_t)row * 32 + h) = v; }
    LDS_BARRIER();
}
__device__ __forceinline__ void sample_mlp_up(const Ctx& c0, int i) {
    PHASE_CTX(c0);
    const bf16_t* XSB = (const bf16_t*)(c.ws + WS_XSB); const float* SSS = (const float*)(c.ws + WS_SSS); const bf16_t* Wt = (const bf16_t*)(c.ws + WS_WUP + i * WUP_STRIDE); bf16_t* HS = (bf16_t*)(c.ws + WS_HS);
    const int fr = c.lane & 15, fq = c.lane >> 4; const int row = 16 * c.wave + fr; const float rs = row_rstd(SSS, 16, row, 1.f / 1024.f);
    for (int tile = c.blk; tile < FF / 16; tile += c.G) {
        f32x4 v = block_gemm_ks<8, 4, true>(c.wave, c.lane, XSB, D, 0, Wt, D, 16 * tile, (LAS float*)c.lds) * rs;
        v.x = fmaxf(v.x, 0.f); v.y = fmaxf(v.y, 0.f); v.z = fmaxf(v.z, 0.f); v.w = fmaxf(v.w, 0.f);
        u32x2 o; o.x = pkbf(v.x * v.x, v.y * v.y); o.y = pkbf(v.z * v.z, v.w * v.w); *(u32x2*)(HS + frag_off(row, phys256(16 * tile + 4 * fq), FF)) = o; }
    LDS_BARRIER();
}
__device__ __forceinline__ void sample_cm_in(const Ctx& c0, int j) {
    PHASE_CTX(c0);
    const bf16_t* XSB = (const bf16_t*)(c.ws + WS_XSB); const float* SSS = (const float*)(c.ws + WS_SSS); const bf16_t* Wt = (const bf16_t*)(c.ws + WS_WCI + j * WCI_STRIDE);
    bf16_t* US = (bf16_t*)(c.ws + WS_US); float* GVS = (float*)(c.ws + WS_GVS); float* SSVS = (float*)(c.ws + WS_SSVS); const float* bias = c.in[16] + (size_t)j * 4096;
    const int fr = c.lane & 15, fq = c.lane >> 4; const int row = 16 * c.wave + fr; const float rs = row_rstd(SSS, 16, row, 1.f / 1024.f);
    for (int tile = c.blk; tile < 4096 / 16; tile += c.G) {
        const int col = 16 * tile + 4 * fq; const f32x4 bv = *(const f32x4*)(bias + col);
        const f32x4 a0 = block_gemm_ks<8, 4, true>(c.wave, c.lane, XSB, D, 0, Wt, D, 16 * tile, (LAS float*)c.lds);
        const f32x4 v = a0 * rs + bv;
        const f32x2 a = pg8::gelu_pk((f32x2){v.x, v.y}), b = pg8::gelu_pk((f32x2){v.z, v.w});
        if (col < CW) { u32x2 o; o.x = pkbf(a.x, a.y); o.y = pkbf(b.x, b.y); *(u32x2*)(US + frag_off(row, phys256(col), CW)) = o; }
        else { *(f32x4*)(GVS + (size_t)row * CW + col - CW) = (f32x4){a.x, a.y, b.x, b.y}; float ss = (a.x * a.x + a.y * a.y) + (b.x * b.x + b.y * b.y);
            ss += __shfl_xor(ss, 16); ss += __shfl_xor(ss, 32); if (fq == 0) SSVS[row * 128 + (tile - 128)] = ss; } }
    LDS_BARRIER();
}

__device__ __forceinline__ void phase_final(const Ctx& c0) {
    PHASE_CTX(c0);
    const int gw = c.blk * NWAVES + c.wave, NGW = c.G * NWAVES; const float* gf = c.in[6];
    f32x4 gv4[4];
#pragma unroll
    for (int jx = 0; jx < 4; ++jx) gv4[jx] = *(const f32x4*)(gf + 4 * c.lane + 256 * jx);
    for (int m0 = 4 * gw; m0 < M; m0 += 4 * NGW) {
        u32x2 p[4][4]; float rs[4];
#pragma unroll
        for (int u = 0; u < 4; ++u) { const int m = m0 + u; rs[u] = row_rstd((const float*)(c.ws + WS_SS), 4, m, 1.f / 1024.f); const bf16_t* x = (const bf16_t*)(c.ws + WS_XB) + (size_t)m * D;
#pragma unroll
            for (int jx = 0; jx < 4; ++jx) p[u][jx] = __builtin_nontemporal_load((const u32x2*)(x + 4 * c.lane + 256 * jx)); }
#pragma unroll
        for (int u = 0; u < 4; ++u) { float* y = c.out + O_Y + (size_t)(m0 + u) * D;
#pragma unroll
            for (int jx = 0; jx < 4; ++jx) { const u32x2 q = p[u][jx]; __builtin_nontemporal_store((f32x4){bf_lo(q.x), bf_hi(q.x), bf_lo(q.y), bf_hi(q.y)} * rs[u] * gv4[jx], (f32x4*)(y + 4 * c.lane + 256 * jx)); } }
    }
    for (int r = gw; r < MS; r += NGW) { const float* x = (const float*)(c.ws + WS_XS) + (size_t)r * D; float* y = c.out + O_YS + (size_t)r * D; const float rsr = row_rstd((const float*)(c.ws + WS_SSS), 16, r, 1.f / 1024.f);
#pragma unroll
        for (int jx = 0; jx < 4; ++jx) { const int col = 4 * c.lane + 256 * jx; *(f32x4*)(y + col) = *(const f32x4*)(x + col) * rsr * gv4[jx]; } }
}
#define XB_TMO      128
#define XB_XCNT(j)  (256  + 64 * (j))
#define XB_XSUB(j)  (1280 + 64 * (j))
#define XB_XGEN(j)  (2304 + 64 * (j))
#define XB_TOP      3328
#define XB_TOPGEN   3392
#define XCD_BAR_WORDS 3456
#define XB_SPIN_CAP (1u << 18)

__device__ __forceinline__ unsigned xb_ld(unsigned* p)              { return __hip_atomic_load(p, __ATOMIC_RELAXED, __HIP_MEMORY_SCOPE_AGENT); }
__device__ __forceinline__ unsigned xb_add(unsigned* p, unsigned v) { return __hip_atomic_fetch_add(p, v, __ATOMIC_RELAXED, __HIP_MEMORY_SCOPE_AGENT); }
__device__ __forceinline__ unsigned xb_xcc_id() { return (unsigned)__builtin_amdgcn_s_getreg((3 << 11) | 20) & 0xFu; }
#define XB_SPIN(cond, bar) do { unsigned _sp = 0; while (cond) { __builtin_amdgcn_s_sleep(1); \
    if ((++_sp & 255u) == 0u) { if (xb_ld(&(bar)[XB_TMO])) break; if (_sp > XB_SPIN_CAP) { atomicAdd(&(bar)[XB_TMO], 1u); break; } } } } while (0)

struct XcdBarrier {
    unsigned* bar; unsigned x;
    volatile LAS unsigned* st;
};

__device__ __forceinline__ XcdBarrier xcd_barrier_post(unsigned* bar, volatile LAS unsigned* st) {
    XcdBarrier b; b.bar = bar; b.x = xb_xcc_id(); b.st = st;
    if (threadIdx.x == 0) (void)xb_add(&bar[XB_XCNT(b.x)], 1u);
    return b;
}
__device__ __forceinline__ void xcd_barrier_complete(unsigned* bar, unsigned x, unsigned& nloc, unsigned& nx) {
    const unsigned G = gridDim.x * gridDim.y * gridDim.z;
    unsigned sum, cnt, mine, sp = 0u;
    for (;;) {
        sum = 0u; cnt = 0u; mine = 0u;
#pragma unroll
        for (unsigned j = 0; j < 16; ++j) { const unsigned c = xb_ld(&bar[XB_XCNT(j)]); sum += c; cnt += (c > 0u) ? 1u : 0u; mine = (j == x) ? c : mine; }
        if (sum == G) break;
        __builtin_amdgcn_s_sleep(1);
        if ((++sp & 255u) == 0u) { if (xb_ld(&bar[XB_TMO])) break; if (sp > XB_SPIN_CAP) { atomicAdd(&bar[XB_TMO], 1u); break; } }
    }
    nloc = mine > 0u ? mine : 1u; nx = cnt > 0u ? cnt : 1u;
}

__device__ __forceinline__ void xcd_barrier(const XcdBarrier& b) {
    asm volatile("s_waitcnt vmcnt(0)" ::: "memory");
    __syncthreads();
    if (threadIdx.x == 0) {
        unsigned* bar = b.bar;
        __builtin_amdgcn_s_waitcnt(0);
        unsigned nloc = b.st[0], nx = b.st[1];
        if (nloc == 0u) { xcd_barrier_complete(bar, b.x, nloc, nx); b.st[0] = nloc; b.st[1] = nx; }
        const unsigned old = xb_add(&bar[XB_XSUB(b.x)], 1u);
        const unsigned gen = old / nloc;
        if (old + 1u == (gen + 1u) * nloc) {
            __builtin_amdgcn_fence(__ATOMIC_RELEASE, "agent");
            asm volatile("s_waitcnt vmcnt(0)" ::: "memory");
            const unsigned og = xb_add(&bar[XB_TOP], 1u);
            asm volatile("buffer_inv sc1" ::: "memory");
            const unsigned tg = og / nx;
            if (og + 1u == (tg + 1u) * nx) xb_add(&bar[XB_TOPGEN], 1u);
            else XB_SPIN(xb_ld(&bar[XB_TOPGEN]) == tg, bar);
            xb_add(&bar[XB_XGEN(b.x)], 1u);
            asm volatile("s_waitcnt vmcnt(0)" ::: "memory");
        } else {
            asm volatile("buffer_inv sc1" ::: "memory");
            XB_SPIN(xb_ld(&bar[XB_XGEN(b.x)]) == gen, bar);
            asm volatile("s_waitcnt vmcnt(0)" ::: "memory");
        }
    }
    __syncthreads();
}

#ifndef PH_MASK
#define PH_MASK 0xffffffffu
#endif
#define PHM(k) ((PH_MASK >> (k)) & 1u)
#ifndef STAGGER
#define STAGGER 1
#endif
#ifndef REP_PRO
#define REP_PRO 1
#endif
#ifndef REP_SSDIN
#define REP_SSDIN 1
#endif
#ifndef REP_SCAN1
#define REP_SCAN1 1
#endif
#ifndef REP_SSAMP
#define REP_SSAMP 1
#endif
#ifndef REP_SCAN2
#define REP_SCAN2 1
#endif
#ifndef REP_UP
#define REP_UP 1
#endif
#ifndef REP_CMIN
#define REP_CMIN 1
#endif
#ifndef REP_RESID
#define REP_RESID 1
#endif
#ifndef REP_SRES
#define REP_SRES 1
#endif
#ifndef REP_MIX
#define REP_MIX 1
#endif
#ifndef REP_FIN
#define REP_FIN 1
#endif
#define REPEAT(n) _Pragma("unroll 1") for (int rep_ = 0; rep_ < (n); ++rep_)
struct Args { const float* in[23]; float* out; unsigned char* ws; int ph_lo, ph_hi; };

__global__ void __launch_bounds__(NTHR, 2) hyb_fwd(Args args) {
    extern __shared__ __attribute__((aligned(16))) unsigned char lds_raw[];
    Ctx c;
#pragma unroll
    for (int i = 0; i < 23; ++i) c.in[i] = args.in[i];
    c.out = args.out; c.ws = args.ws;
    c.lds = (LAS unsigned char*)lds_raw;
    c.tid = threadIdx.x; c.lane = c.tid & 63; c.wave = __builtin_amdgcn_readfirstlane(c.tid >> 6); c.blk = blockIdx.x; c.G = gridDim.x;
    volatile LAS unsigned* lctl = (volatile LAS unsigned*)(c.lds + LDSCTL_OFF);
    if (c.tid < 128) lctl[c.tid] = 0u;
    __syncthreads();
    const int lo = args.ph_lo, hi = args.ph_hi;
    XcdBarrier bar; bar.bar = (unsigned*)(c.ws + WS_CTL) + CW_BAR; bar.x = 0; bar.st = lctl;
    if (hi - lo > 1) bar = xcd_barrier_post((unsigned*)(c.ws + WS_CTL) + CW_BAR, lctl);

#pragma unroll 1
    for (int ph_ = lo; ph_ < hi; ++ph_) {
        int ph = ph_; asm volatile("" : "+s"(ph));
        int L = 0, idx = 0, kind;
        if (ph == 0) kind = 0;
        else if (ph == NPHASE - 1) kind = 8;
        else { const int q = ph - 1;
            if (q < 6) { L = 0; idx = q; } else if (q < 11) { L = 1; idx = q - 6; } else if (q < 17) { L = 2; idx = q - 11; } else { L = 3; idx = q - 17; }
            if ((L & 1) == 0) kind = idx == 0 ? 1 : idx == 1 ? 2 : idx == 2 ? 3 : idx == 3 ? 4 : idx == 4 ? 7 : 4;
            else kind = idx == 0 ? 5 : idx == 1 ? 6 : idx == 2 ? 4 : idx == 3 ? 7 : 4; }
        const int j = L >> 1;
        bf16_t* const XB = (bf16_t*)(c.ws + WS_XB); float* const SS = (float*)(c.ws + WS_SS);
        if (kind == 0) { REPEAT(REP_PRO) { phase_prologue(c); if (rep_ + 1 < REP_PRO) __syncthreads(); } }
        else if (kind == 1) {
            REPEAT(REP_SSDIN) {
            const bool late = STAGGER && ((c.blk >> 3) & 1);
            if (!late) { sample_ssd_in(c, j); prompt_dt(c, j); }
            pg8::Gemm g{XB, (const bf16_t*)(c.ws + WS_WSI + j * WSI_STRIDE), M, INMAIN, D}; pg8::StaticOrder S; S.init(M, INMAIN, c.G, c.blk);
            pg8::EpiSsdIn E{(const LAS float*)(c.lds + RSTAB_OFF), (bf16_t*)(c.ws + WS_ZS), (bf16_t*)(c.ws + WS_XBC), c.out + O_CONVP + (size_t)j * NB * 3 * CONVD, c.lds + EPISCR_OFF, c.lds, SS, c.blk};
            pg8::gemm_phase<pg8::EpiSsdIn, pg8::StaticOrder, true, true>(c.lds, g, S, E, c.wave);
            if (late) { sample_ssd_in(c, j); prompt_dt(c, j); } }
        }
        else if (kind == 2) { REPEAT(REP_SCAN1) phase_conv(c, j); }
        else if (kind == 3) { REPEAT(REP_SCAN2) phase_ssd_scan(c, j); }
        else if (kind == 4) {
            const bool ssd = (L & 1) == 0; const bool down = ssd ? idx == 5 : idx == 4;
            const bf16_t* A = (const bf16_t*)(c.ws + (down ? WS_HB : ssd ? WS_YN : WS_ZS));
            const bf16_t* As = (const bf16_t*)(c.ws + (down ? WS_HS : ssd ? WS_YNS : WS_US));
            const bf16_t* Wt = (const bf16_t*)(c.ws + (down ? WS_WDN + L * WDN_STRIDE : ssd ? WS_WSO + j * WSO_STRIDE : WS_WCO + j * WCO_STRIDE));
            const int K = down ? FF : DI;
            const bool first = (L == 0) && !down;
            const float* xsbase = first ? c.in[1] : (const float*)(c.ws + WS_XS);
            REPEAT(REP_SRES - 1) sample_resid(c, As, K, Wt, xsbase, 800 * MiB);
            sample_resid(c, As, K, Wt, xsbase);
            pg8::Gemm g{A, Wt, M, D, K}; pg8::StaticOrder S; S.init(M, D, c.G, c.blk);
            if (ssd && !down) {
                pg8::EpiResidG E{XB, SS, (const LAS float*)(c.lds + RGTAB_OFF), c.lds, (const float*)(c.ws + WS_SSY), c.blk};
                pg8::gemm_phase<pg8::EpiResidG, pg8::StaticOrder, true, true, true>(c.lds, g, S, E, c.wave);
            } else {
                pg8::EpiResid E{XB, SS};
                pg8::gemm_phase<pg8::EpiResid, pg8::StaticOrder, true, true, true>(c.lds, g, S, E, c.wave);
            }
        }
        else if (kind == 5) {
            REPEAT(REP_CMIN) {
            const bool late = STAGGER && ((c.blk >> 3) & 1);
            if (!late) sample_cm_in(c, j);
            pg8::Gemm g{XB, (const bf16_t*)(c.ws + WS_WCI + j * WCI_STRIDE), M, 4096, D}; pg8::StaticOrder S; S.init(M, 4096, c.G, c.blk);
            pg8::EpiCmIn E{(const LAS float*)(c.lds + RSTAB_OFF), c.in[16] + (size_t)j * 4096, (bf16_t*)(c.ws + WS_ZS), (bf16_t*)(c.ws + WS_XBC), (float*)(c.ws + WS_SSV), c.lds + EPISCR_OFF, c.lds, SS, c.blk};
            pg8::gemm_phase<pg8::EpiCmIn, pg8::StaticOrder, true, true>(c.lds, g, S, E, c.wave);
            if (late) sample_cm_in(c, j); }
        }
        else if (kind == 6) { REPEAT(REP_MIX - 1) phase_cm_mix(c, j, (bf16_t*)(c.ws + 700 * MiB), false); phase_cm_mix(c, j, (bf16_t*)(c.ws + WS_ZS), true); }
        else if (kind == 7) {
            REPEAT(REP_UP) {
            const bool late = STAGGER && ((c.blk >> 3) & 1);
            if (!late) sample_mlp_up(c, L);
#ifdef REP_UPX
            REPEAT(REP_UPX) { pg8::Gemm g0{XB, (const bf16_t*)(c.ws + WS_WUP + L * WUP_STRIDE), M, FF, D}; pg8::StaticOrder S0; S0.init(M, FF, c.G, c.blk);
                pg8::EpiMlpUp E0{(const LAS float*)(c.lds + RSTAB_OFF), (bf16_t*)(c.ws + 700 * MiB), c.lds + EPISCR_OFF, c.lds, SS, c.blk, UPX_MODE}; pg8::gemm_phase<pg8::EpiMlpUp, pg8::StaticOrder, true, true>(c.lds, g0, S0, E0, c.wave); }
#endif
#ifdef REP_UPNULL
            REPEAT(REP_UPNULL) { pg8::Gemm g0{XB, (const bf16_t*)(c.ws + WS_WUP + L * WUP_STRIDE), M, FF, D}; pg8::StaticOrder S0; S0.init(M, FF, c.G, c.blk); pg8::EpiNull E0; pg8::gemm_phase<pg8::EpiNull, pg8::StaticOrder, true, true>(c.lds, g0, S0, E0, c.wave); }
#endif
            pg8::Gemm g{XB, (const bf16_t*)(c.ws + WS_WUP + L * WUP_STRIDE), M, FF, D}; pg8::StaticOrder S; S.init(M, FF, c.G, c.blk);
            pg8::EpiMlpUp E{(const LAS float*)(c.lds + RSTAB_OFF), (bf16_t*)(c.ws + WS_HB), c.lds + EPISCR_OFF, c.lds, SS, c.blk};
            pg8::gemm_phase<pg8::EpiMlpUp, pg8::StaticOrder, true, true>(c.lds, g, S, E, c.wave);
            if (late) sample_mlp_up(c, L); }
        }
        else { REPEAT(REP_FIN) phase_final(c); }
        if (ph_ + 1 < hi) { xcd_barrier(bar);
#ifdef REP_BAR
            xcd_barrier(bar);
#endif
        }
    }
}

extern "C" void kernel_launch(void* const* d_in, const int* in_sizes, int n_in, void* d_out, int out_size, void* d_ws, size_t ws_size, hipStream_t stream) {
    static int grid = 0;
    if (grid == 0) {
        if (n_in != 23 || in_sizes[0] != M * D || (size_t)out_size != O_END || ws_size < 900 * MiB) {
            fprintf(stderr, "kernel_launch: unexpected shapes (n_in %d, in0 %d, out %d, ws %zu); nothing launched\n", n_in, n_in > 0 ? in_sizes[0] : -1, out_size, ws_size); grid = -1; return; }
        int dev = 0, cus = 0, per_cu = 0;
        if (hipGetDevice(&dev) != hipSuccess || hipDeviceGetAttribute(&cus, hipDeviceAttributeMultiprocessorCount, dev) != hipSuccess) { fprintf(stderr, "kernel_launch: device query failed\n"); grid = -1; return; }
        if (hipFuncSetAttribute((const void*)hyb_fwd, hipFuncAttributeMaxDynamicSharedMemorySize, LDS_BYTES) != hipSuccess) { fprintf(stderr, "kernel_launch: hipFuncSetAttribute failed\n"); grid = -1; return; }
        if (hipOccupancyMaxActiveBlocksPerMultiprocessor(&per_cu, (const void*)hyb_fwd, NTHR, LDS_BYTES) != hipSuccess || per_cu < 1)
            fprintf(stderr, "kernel_launch: note: occupancy query reports %d workgroups per CU\n", per_cu);
        (void)hipGetLastError();
        grid = cus;
    }
    if (grid < 0) return;
    (void)hipMemsetAsync((char*)d_ws + WS_CTL, 0, CTL_ZERO_BYTES, stream);
    Args a{};
    for (int i = 0; i < 23; ++i) a.in[i] = (const float*)d_in[i];
    a.out = (float*)d_out; a.ws = (unsigned char*)d_ws;
#if MK_N_LAUNCHES == 1
    a.ph_lo = 0; a.ph_hi = NPHASE;
    hipLaunchKernelGGL(hyb_fwd, dim3(grid), dim3(NTHR), LDS_BYTES, stream, a);
#else
    for (int p = 0; p < NPHASE; ++p) { a.ph_lo = p; a.ph_hi = p + 1; hipLaunchKernelGGL(hyb_fwd, dim3(grid), dim3(NTHR), LDS_BYTES, stream, a); }
#endif
}
```
